# Optimizing an MI355X kernel written in HIP

```python
import jax, jax.numpy as jnp
from jax import lax
import numpy as np

D_MODEL = 2048
BATCH = 2
SEQ = 8192
DEPTH = 1

CTX_LEN = 256
GRID_W = 64

RW_HEAD = 64
RW_WIDTH = D_MODEL // 2
RW_HEADS = RW_WIDTH // RW_HEAD
DECAY_LORA = 64
AAA_LORA = 64
CONV_W = 3
GN_EPS = 64e-5

MLA_HEADS = 8
QK_NOPE = 128
QK_ROPE = 64
QK_DIM = QK_NOPE + QK_ROPE
V_HEAD = 128
MLA_WIDTH = MLA_HEADS * V_HEAD
Q_LORA = 512
KV_LORA = 256
ROPE_BASE = 10000.0
Q_BLOCK = 128

EPS = 1e-6

IN_WIDTHS = (3 * RW_WIDTH,
             RW_WIDTH,
             2 * DECAY_LORA,
             2 * AAA_LORA,
             Q_LORA,
             KV_LORA,
             QK_ROPE,
             MLA_WIDTH,
             2 * D_MODEL)
IN_WIDTH = sum(IN_WIDTHS)

kernel_name = "hybrid_rwkv7_mla_prefix_dit_block"

f32 = jnp.float32


def rmsnorm(x, w):
    xf = x.astype(f32)
    y = xf * lax.rsqrt(jnp.mean(xf * xf, axis=-1, keepdims=True) + EPS)
    return (y * w.astype(f32)).astype(x.dtype)


def modulation(cond, w_mod, b_mod):
    m = (jax.nn.silu(cond) @ w_mod + b_mod).reshape(-1, 1, 3 * D_MODEL)
    return jnp.split(m, 3, axis=-1)


def split_in(u):
    offs, acc = [], 0
    for w in IN_WIDTHS[:-1]:
        acc += w
        offs.append(acc)
    return jnp.split(u, offs, axis=-1)


def project_stream(h, norm_w, shift, scale, w_in):
    hm = rmsnorm(h, norm_w) * (1 + scale) + shift
    return split_in(hm @ w_in)


def centred_short_conv(u, w):
    up = jnp.pad(u, ((0, 0), (1, 1), (0, 0)))
    return up[:, :-2] * w[0] + up[:, 1:-1] * w[1] + up[:, 2:] * w[2]


def rwkv_prepare(u_rkv, u_wd, u_ad, conv_w, w0, w_decay_up, a0, w_a_up, k_k, k_a):
    B, L, _ = u_rkv.shape
    r, k, v = jnp.split(centred_short_conv(u_rkv, conv_w), 3, axis=-1)
    wd = jnp.tanh(u_wd.reshape(B, L, 2, DECAY_LORA))
    w_log = (w0 + jnp.einsum("bldr,drc->bldc", wd, w_decay_up)).astype(f32)
    decay = jnp.exp(-jnp.exp(-jax.nn.softplus(-w_log) - 0.5))
    a = jax.nn.sigmoid((a0 + jnp.einsum("bldr,drc->bldc",
                                        u_ad.reshape(B, L, 2, AAA_LORA), w_a_up)).astype(f32))
    kk = (k * k_k).reshape(B, L, RW_HEADS, RW_HEAD).astype(f32)
    kk = (kk * lax.rsqrt(jnp.sum(kk * kk, -1, keepdims=True) + 1e-12)).reshape(B, L, RW_WIDTH)
    k_mod = k[:, :, None, :].astype(f32) * (1 + (a - 1) * k_a.astype(f32))
    return r, v, kk, decay, a, k_mod


def to_scan_layout(t):
    B, L = t.shape[:2]
    t = t.reshape(B, L, 2, RW_HEADS, RW_HEAD).transpose(1, 2, 0, 3, 4).astype(f32)
    return jnp.stack([t[:, 0], jnp.flip(t[:, 1], 0)], axis=1)


def rwkv7_step(S, xs):
    r, w, k, v, kk, akk = xs
    sa = jnp.einsum("dbhij,dbhj->dbhi", S, -kk)
    S = S * w[..., None, :] + sa[..., :, None] * akk[..., None, :] + v[..., :, None] * k[..., None, :]
    return S, jnp.einsum("dbhij,dbhj->dbhi", S, r)


def rwkv_scan(r, v, kk, decay, a, k_mod, S0):
    B, L, _ = r.shape
    both = lambda t: jnp.broadcast_to(t[:, :, None, :], (B, L, 2, RW_WIDTH))
    xs = (to_scan_layout(both(r)), to_scan_layout(decay), to_scan_layout(k_mod),
          to_scan_layout(both(v)), to_scan_layout(both(kk)),
          to_scan_layout(a * kk[:, :, None, :]))
    S, ys = lax.scan(rwkv7_step, S0, xs)
    y = ys[:, 0] + jnp.flip(ys[:, 1], 0)
    return S, y.transpose(1, 0, 2, 3)


def rwkv_finish(r, v, k_mod, y, z, r_k, ln_w, ln_b):
    B, L, _ = r.shape
    mu = jnp.mean(y, -1, keepdims=True)
    var = jnp.mean(jnp.square(y - mu), -1, keepdims=True)
    yn = ((y - mu) * lax.rsqrt(var + GN_EPS)).reshape(B, L, RW_WIDTH) * ln_w + ln_b
    coef = jnp.einsum("blhn,bldhn,hn->blh", r.reshape(B, L, RW_HEADS, RW_HEAD).astype(f32),
                      k_mod.reshape(B, L, 2, RW_HEADS, RW_HEAD), r_k.astype(f32))
    bonus = (coef[..., None] * v.reshape(B, L, RW_HEADS, RW_HEAD).astype(f32)).reshape(B, L, RW_WIDTH)
    return (yn + bonus).astype(z.dtype) * jax.nn.silu(z)


def axial_rope_tables(rows):
    r_pos = jnp.broadcast_to(jnp.arange(rows)[:, None], (rows, GRID_W)).reshape(-1).astype(f32)
    c_pos = jnp.broadcast_to(jnp.arange(GRID_W)[None, :], (rows, GRID_W)).reshape(-1).astype(f32)
    axis_dim = QK_ROPE // 2
    inv = jnp.power(ROPE_BASE, -jnp.arange(0, axis_dim, 2, dtype=f32) / axis_dim)
    ang_r, ang_c = r_pos[:, None] * inv, c_pos[:, None] * inv
    return jnp.cos(ang_r), jnp.sin(ang_r), jnp.cos(ang_c), jnp.sin(ang_c)


def rope_axis(x, cos, sin):
    x1, x2 = jnp.split(x, 2, axis=-1)
    cos, sin = cos[None, :, None, :], sin[None, :, None, :]
    return jnp.concatenate([x1 * cos - x2 * sin, x2 * cos + x1 * sin], axis=-1)


def apply_axial_rope(x, tables):
    cos_r, sin_r, cos_c, sin_c = tables
    nope, rot = x[..., :QK_NOPE], x[..., QK_NOPE:].astype(f32)
    xr, xc = jnp.split(rot, 2, axis=-1)
    rot = jnp.concatenate([rope_axis(xr, cos_r, sin_r), rope_axis(xc, cos_c, sin_c)], axis=-1)
    return jnp.concatenate([nope, rot.astype(x.dtype)], axis=-1)


def mla_qkv(q_dn, kv_dn, k_rope, q_norm_w, w_uq, kv_norm_w, w_ukv, q_gain, k_gain, rope):
    B, L, _ = q_dn.shape
    q = (rmsnorm(q_dn, q_norm_w) @ w_uq).reshape(B, L, MLA_HEADS, QK_DIM)
    kv = (rmsnorm(kv_dn, kv_norm_w) @ w_ukv).reshape(B, L, MLA_HEADS, QK_NOPE + V_HEAD)
    k_nope, v = kv[..., :QK_NOPE], kv[..., QK_NOPE:]
    k = jnp.concatenate([k_nope, jnp.broadcast_to(k_rope[:, :, None, :], (B, L, MLA_HEADS, QK_ROPE))], -1)
    q, k = rmsnorm(q, q_gain), rmsnorm(k, k_gain)
    if rope is not None:
        q, k = apply_axial_rope(q, rope), apply_axial_rope(k, rope)
    return q, k, v


def attend(q, k, v):
    s = jnp.einsum("bqhd,bkhd->bhqk", q, k).astype(f32) * (QK_DIM ** -0.5)
    p = jax.nn.softmax(s, axis=-1).astype(v.dtype)
    return jnp.einsum("bhqk,bkhd->bqhd", p, v)


def blocked_attend(q, k, v):
    B, L, H, Dq = q.shape
    qb = q.reshape(B, L // Q_BLOCK, Q_BLOCK, H, Dq).transpose(1, 0, 2, 3, 4)
    out = lax.map(lambda qi: attend(qi, k, v), qb)
    return out.transpose(1, 0, 2, 3, 4).reshape(B, L, H * V_HEAD)


def merge_branches(o_rwkv, o_mla, gate_logits, w_br_r, w_br_m, w_out):
    g_r, g_m = jnp.split(jax.nn.sigmoid(gate_logits), 2, axis=-1)
    return (g_r * (o_rwkv @ w_br_r) + g_m * (o_mla @ w_br_m)) @ w_out


def setup_inputs(seed: int = 0) -> dict:
    key = jax.random.key(seed)
    ks = iter(jax.random.split(key, 32))
    nrm = lambda shape, s: jax.random.normal(next(ks), shape, f32) * s
    D = D_MODEL
    conv_centre = jnp.array([0.0, 1.0, 0.0], f32)[None, :, None]
    return {
        "x": nrm((BATCH, SEQ, D), 1.0),
        "c": nrm((BATCH, D), 1.0),
        "ctx": nrm((BATCH, CTX_LEN, D), 1.0),
        "c_ctx": nrm((D,), 1.0),
        "norm_w": 1.0 + nrm((DEPTH, D), 0.05),
        "w_mod": nrm((DEPTH, D, 3 * D), 0.5 * D ** -0.5),
        "b_mod": nrm((DEPTH, 3 * D), 0.01),
        "w_in": nrm((DEPTH, D, IN_WIDTH), D ** -0.5),
        "conv_rkv": conv_centre + nrm((DEPTH, CONV_W, 3 * RW_WIDTH), 0.2),
        "w0": jax.random.uniform(next(ks), (DEPTH, 2, RW_WIDTH), f32, -4.0, 1.0),
        "w_decay_up": nrm((DEPTH, 2, DECAY_LORA, RW_WIDTH), 0.1 * DECAY_LORA ** -0.5),
        "a0": nrm((DEPTH, 2, RW_WIDTH), 0.5),
        "w_a_up": nrm((DEPTH, 2, AAA_LORA, RW_WIDTH), 0.5 * AAA_LORA ** -0.5),
        "k_k": 0.85 + nrm((DEPTH, RW_WIDTH), 0.05),
        "k_a": 1.0 + nrm((DEPTH, RW_WIDTH), 0.05),
        "r_k": nrm((DEPTH, RW_HEADS, RW_HEAD), 0.1),
        "ln_x_w": 1.0 + nrm((DEPTH, RW_WIDTH), 0.05),
        "ln_x_b": nrm((DEPTH, RW_WIDTH), 0.01),
        "q_norm_w": 1.0 + nrm((DEPTH, Q_LORA), 0.05),
        "w_uq": nrm((DEPTH, Q_LORA, MLA_HEADS * QK_DIM), Q_LORA ** -0.5),
        "kv_norm_w": 1.0 + nrm((DEPTH, KV_LORA), 0.05),
        "w_ukv": nrm((DEPTH, KV_LORA, MLA_HEADS * (QK_NOPE + V_HEAD)), KV_LORA ** -0.5),
        "q_gain": 1.0 + nrm((DEPTH, QK_DIM), 0.05),
        "k_gain": 1.0 + nrm((DEPTH, QK_DIM), 0.05),
        "w_branch_rwkv": nrm((DEPTH, RW_WIDTH, D), RW_WIDTH ** -0.5),
        "w_branch_mla": nrm((DEPTH, MLA_WIDTH, D), MLA_WIDTH ** -0.5),
        "w_out": nrm((DEPTH, D, D), D ** -0.5),
    }


def reference(x, c, ctx, c_ctx, norm_w, w_mod, b_mod, w_in, conv_rkv, w0, w_decay_up, a0,
              w_a_up, k_k, k_a, r_k, ln_x_w, ln_x_b, q_norm_w, w_uq, kv_norm_w, w_ukv,
              q_gain, k_gain, w_branch_rwkv, w_branch_mla, w_out):
    B, L, _ = x.shape
    ROWS = L // GRID_W
    rope = axial_rope_tables(ROWS)
    for i in range(DEPTH):
        last = i == DEPTH - 1
        sh_x, sc_x, g_x = modulation(c, w_mod[i], b_mod[i])
        sh_c, sc_c, g_c = modulation(c_ctx, w_mod[i], b_mod[i])
        (rkv_x, zr_x, wd_x, ad_x, qd_x, kvd_x, kr_x, zm_x, mg_x) = project_stream(x, norm_w[i], sh_x, sc_x, w_in[i])
        (rkv_c, zr_c, wd_c, ad_c, qd_c, kvd_c, kr_c, zm_c, mg_c) = project_stream(ctx, norm_w[i], sh_c, sc_c, w_in[i])

        rw = (conv_rkv[i], w0[i], w_decay_up[i], a0[i], w_a_up[i], k_k[i], k_a[i])
        r_c, v_c, kk_c, dec_c, a_c, km_c = rwkv_prepare(rkv_c, wd_c, ad_c, *rw)
        r_x, v_x, kk_x, dec_x, a_x, km_x = rwkv_prepare(rkv_x, wd_x, ad_x, *rw)
        S0 = jnp.zeros((2, B, RW_HEADS, RW_HEAD, RW_HEAD), f32)
        S_ctx, y_c = rwkv_scan(r_c, v_c, kk_c, dec_c, a_c, km_c, S0)
        _, y_x = rwkv_scan(r_x, v_x, kk_x, dec_x, a_x, km_x, S_ctx)
        o_rw_x = rwkv_finish(r_x, v_x, km_x, y_x, zr_x, r_k[i], ln_x_w[i], ln_x_b[i])

        ml = (q_norm_w[i], w_uq[i], kv_norm_w[i], w_ukv[i], q_gain[i], k_gain[i])
        q_c, k_c, v_c_att = mla_qkv(qd_c, kvd_c, kr_c, *ml, None)
        q_x, k_x, v_x_att = mla_qkv(qd_x, kvd_x, kr_x, *ml, rope)
        att_x = blocked_attend(q_x, jnp.concatenate([k_x, k_c], axis=1),
                               jnp.concatenate([v_x_att, v_c_att], axis=1))
        o_ml_x = att_x * jax.nn.silu(zm_x)

        x_new = x + g_x * merge_branches(o_rw_x, o_ml_x, mg_x, w_branch_rwkv[i], w_branch_mla[i], w_out[i])
        if not last:
            o_rw_c = rwkv_finish(r_c, v_c, km_c, y_c, zr_c, r_k[i], ln_x_w[i], ln_x_b[i])
            o_ml_c = attend(q_c, k_c, v_c_att).reshape(B, -1, MLA_WIDTH) * jax.nn.silu(zm_c)
            ctx = ctx + g_c * merge_branches(o_rw_c, o_ml_c, mg_c, w_branch_rwkv[i], w_branch_mla[i], w_out[i])
        x = x_new
    return x
```

```cpp
#include <hip/hip_runtime.h>
#include <hip/hip_cooperative_groups.h>
#include <cstdio>
#include <cstdint>
namespace cg = cooperative_groups;

#ifndef MK_N_LAUNCHES
#define MK_N_LAUNCHES 1
#endif

constexpr int DM = 2048, NB = 2, SEQ = 8192, CTXL = 256;
constexpr int TX = NB * SEQ, TC = NB * CTXL, TT = TX + TC;
constexpr int RW = 1024, RH = 16, RN = 64;
constexpr int MH = 8, QKD = 192, NOPE = 128, ROPE = 64, VH = 128;
constexpr int QL = 512, KVL = 256;
constexpr int NIN = 10496;
constexpr float EPS = 1e-6f, GN_EPS = 64e-5f;
constexpr int LD_RKV = 3072, LD_Z = 2048, LD_SM = 1280, LD_MG = 4096, LD_LW = 4096, LD_Q = 1536, LD_KV = 2048, LD_KR = 512;

typedef unsigned short bf16_t;
typedef short bf16x8 __attribute__((ext_vector_type(8)));
typedef float f32x4 __attribute__((ext_vector_type(4)));
typedef float f32x2 __attribute__((ext_vector_type(2)));
typedef float f32x16 __attribute__((ext_vector_type(16)));
typedef unsigned u32x4 __attribute__((ext_vector_type(4)));
typedef unsigned u32x2 __attribute__((ext_vector_type(2)));
typedef short s16x4 __attribute__((ext_vector_type(4)));
#define LAS __attribute__((address_space(3)))

constexpr size_t MiB = 1u << 20;
constexpr size_t WS_CTL = 0;
constexpr size_t WS_MOD = 1 * MiB;
constexpr size_t WS_WUQ = 2 * MiB;
constexpr size_t WS_WUKV = WS_WUQ + (size_t)1536 * 512 * 2;
constexpr size_t WS_WLORA = WS_WUKV + (size_t)2048 * 256 * 2;
constexpr size_t WS_WBR = WS_WLORA + (size_t)4096 * 256 * 2;
constexpr size_t WS_WBM = WS_WBR + (size_t)2048 * 1024 * 2;
constexpr size_t WS_WOUT = WS_WBM + (size_t)2048 * 1024 * 2;
constexpr size_t WS_URKV = 23 * MiB;
constexpr size_t WS_UZ = 122 * MiB;
constexpr size_t WS_USM = 186 * MiB;
constexpr size_t WS_WIN = 228 * MiB;
constexpr size_t WS_HM = 269 * MiB;
constexpr size_t WS_SCAN = 228 * MiB;
constexpr size_t WS_COEF = 492 * MiB;
constexpr size_t WS_QRAW = 228 * MiB;
constexpr size_t WS_KV = 276 * MiB;
constexpr size_t WS_KR = 342 * MiB;
constexpr size_t WS_MB = 228 * MiB;
constexpr size_t WS_END = 512 * MiB;
constexpr int REC_BYTES = 4 * 8192;
static_assert(WS_WOUT + (size_t)2048 * 2048 * 2 <= WS_URKV, "weights fit");
static_assert(WS_URKV + (size_t)TT * LD_RKV * 2 <= WS_UZ && WS_UZ + (size_t)TX * 2048 * 2 <= WS_USM && WS_USM + (size_t)TT * LD_SM * 2 <= WS_WIN, "U map");
static_assert(WS_WIN + (size_t)NIN * DM * 2 <= WS_HM && WS_HM + (size_t)TT * DM * 2 <= WS_END, "P2 map");
static_assert(WS_SCAN + (size_t)64 * 132 * REC_BYTES <= WS_COEF && WS_COEF + (size_t)2 * TX * 16 * 4 <= WS_END, "scan map");
static_assert(WS_QRAW + (size_t)TX * LD_Q * 2 <= WS_KV && WS_KV + (size_t)TT * LD_KV * 2 <= WS_KR && WS_KR + (size_t)TT * LD_KR * 2 <= WS_COEF, "mla map");
static_assert(WS_MB + (size_t)TX * DM * 2 <= WS_END, "merge map");

__device__ __forceinline__ unsigned f2bf(float f) { unsigned u = __builtin_bit_cast(unsigned, f); return (u + 0x7fffu + ((u >> 16) & 1u)) >> 16; }
__device__ __forceinline__ unsigned pk2(float lo, float hi) { return f2bf(lo) | (f2bf(hi) << 16); }
__device__ __forceinline__ float bf2f(unsigned short h) { return __builtin_bit_cast(float, (unsigned)h << 16); }
__device__ __forceinline__ float bflo(unsigned w) { return __builtin_bit_cast(float, w << 16); }
__device__ __forceinline__ float bfhi(unsigned w) { return __builtin_bit_cast(float, w & 0xffff0000u); }
typedef __bf16 bf16x2_t __attribute__((ext_vector_type(2)));
__device__ __forceinline__ unsigned cvt_pk_bf16(float lo, float hi) { const f32x2 v = {lo, hi}; const bf16x2_t b = __builtin_convertvector(v, bf16x2_t); return __builtin_bit_cast(unsigned, b); }
__device__ __forceinline__ float fast_sigmoid(float x) { return __builtin_amdgcn_rcpf(1.0f + __expf(-x)); }
__device__ __forceinline__ float sigmoidf_(float x) { return 1.0f / (1.0f + __expf(-x)); }
__device__ __forceinline__ float siluf_(float x) { return x / (1.0f + __expf(-x)); }
__device__ __forceinline__ float wave_sum(float v) {
#pragma unroll
    for (int o = 1; o < 64; o <<= 1) v += __shfl_xor(v, o);
    return v;
}
#define LDS_WAIT() asm volatile("s_waitcnt lgkmcnt(0)" ::: "memory")
#define VM_WAIT() asm volatile("s_waitcnt vmcnt(0)" ::: "memory")

namespace pg8 {
constexpr int BM = 256, BK = 64, HALF = 128, HTB = HALF * BK * 2  , STAGE_BYTES = 8 * HTB, NXCD = 8, WGM = 8;
__host__ __device__ __forceinline__ int lds_byte(int r, int c) { const int st = (r >> 4) * 2 + (c >> 5), rr = r & 15, cc = c & 31, ob = rr * 64 + cc * 2; return st * 1024 + (ob ^ (((ob >> 9) & 1) << 5)); }
__host__ __device__ __forceinline__ void stage_rc(int b, int& R, int& C) { const int st = b / 1024, sb = b % 1024, swz = sb ^ (((sb >> 9) & 1) << 5); R = (st >> 1) * 16 + swz / 64; C = (st & 1) * 32 + (swz % 64) / 2; }
__host__ __device__ __forceinline__ int perm32(int rho) { const int n = rho >> 4, i = rho & 15; return 8 * (i >> 2) + 4 * n + (i & 3); }

struct Unit { int pm, pn, kofs; };
struct Gemm { const bf16_t* A; const bf16_t* Bt; int M, N, K, lda, ldb; };

struct StaticOrder {
    int nM, nN, nwg, G, c;
    __host__ __device__ void init(int M, int N, int G_, int c_) { nM = M / BM; nN = N / BM; nwg = nM * nN; G = G_; c = c_; }
    __host__ __device__ bool next(int i, Unit& u) const {
        const long L = (long)i * G + c; if (L >= nwg) return false;
        int wgid = (int)L; { const int q = nwg / NXCD, r = nwg % NXCD, xcd = wgid % NXCD, off = wgid / NXCD; wgid = (xcd < r ? xcd * (q + 1) : r * (q + 1) + (xcd - r) * q) + off; }
        const int nig = WGM * nN, gid = wgid / nig, fm = gid * WGM, gsz = (nM - fm) < WGM ? (nM - fm) : WGM;
        u.pm = fm + ((wgid % nig) % gsz); u.pn = (wgid % nig) / gsz; u.kofs = 0; return true;
    }
};
struct ChainOrder { StaticOrder S; int KH;
    __host__ __device__ bool next(int i, Unit& u) const { if (!S.next(i >> 1, u)) return false; u.kofs = (i & 1) * KH; return true; } };

template <class Epi, class Sched = StaticOrder, bool ALIGN_EPI = true, bool SP2 = true>
__device__ __forceinline__ void gemm_phase(LAS unsigned char* lds, const Gemm g, const Sched& S, const Epi& E) {
    const int tid = threadIdx.x, wid = __builtin_amdgcn_readfirstlane(tid >> 6), lane = tid & 63, wr = wid >> 2, wc = wid & 3, fr = lane & 15, fq = lane >> 4;
    const int K = g.K, nt = K / BK;
    unsigned voffA[2], voffB[2];
#pragma unroll
    for (int i = 0; i < 2; ++i) { int R, C; stage_rc(tid * 16 + i * 8192, R, C); const int Rb = Epi::PERM ? ((R & ~31) + perm32(R & 31)) : R;
        voffA[i] = (unsigned)(R * g.lda + C) * 2u; voffB[i] = (unsigned)(Rb * g.ldb + C) * 2u; }
    const size_t kstep = (size_t)(BK * 2);
    const size_t hstepA = (size_t)HALF * g.lda * 2, hstepB = (size_t)HALF * g.ldb * 2;
    const size_t tstepA = 2 * hstepA, tstepB = 2 * hstepB;
    const unsigned ldsw = (unsigned)wid * 1024u;
    const int aoff = lds_byte(wr * 64 + fr, fq * 8), boff = lds_byte(wc * 32 + fr, fq * 8);
#define PG8_SA(b, h) (((b) * 2 + (h)) * HTB)
#define PG8_SB(b, h) ((4 + (b) * 2 + (h)) * HTB)
#define PG8_STAGE(bufoff, gbase, voff) do { _Pragma("unroll") for (int _i = 0; _i < 2; ++_i) \
        __builtin_amdgcn_global_load_lds((const unsigned*)((const char*)(gbase) + (voff)[_i]), (LAS unsigned*)(lds + (bufoff) + ldsw + _i * 8192), 16, 0, 0); } while (0)
#define PG8_LDA(dst, b, h) do { _Pragma("unroll") for (int m = 0; m < 4; ++m) _Pragma("unroll") for (int k = 0; k < 2; ++k) dst[m][k] = *(const LAS bf16x8*)(lds + PG8_SA(b, h) + aoff + m * 2048 + k * 1024); } while (0)
#define PG8_LDB(dst, b, h) do { _Pragma("unroll") for (int n = 0; n < 2; ++n) _Pragma("unroll") for (int k = 0; k < 2; ++k) dst[n][k] = *(const LAS bf16x8*)(lds + PG8_SB(b, h) + boff + n * 2048 + k * 1024); } while (0)
#define PG8_MMA(ai, bj, At, Bt) do { __builtin_amdgcn_s_setprio(1); _Pragma("unroll") for (int m = 0; m < 4; ++m) _Pragma("unroll") for (int n = 0; n < 2; ++n) _Pragma("unroll") for (int k = 0; k < 2; ++k) \
        acc[ai][bj][m][n] = __builtin_amdgcn_mfma_f32_16x16x32_bf16(Bt[n][k], At[m][k], acc[ai][bj][m][n], 0, 0, 0); __builtin_amdgcn_s_setprio(0); } while (0)
#define PG8_WAIT_V(n) asm volatile("s_waitcnt vmcnt(" #n ")" ::: "memory")
#define PG8_WAIT_L(n) asm volatile("s_waitcnt lgkmcnt(" #n ")" ::: "memory")
#define PG8_BAR __builtin_amdgcn_s_barrier()
#define PG8_SCHED __builtin_amdgcn_sched_barrier(0)
    Unit cur, nxt; int ui = 0;
    if (!S.next(0, cur)) return;
    f32x4 acc[2][2][4][2];
#pragma unroll
    for (int a = 0; a < 2; ++a)
#pragma unroll
        for (int b = 0; b < 2; ++b)
#pragma unroll
            for (int m = 0; m < 4; ++m)
#pragma unroll
                for (int n = 0; n < 2; ++n) acc[a][b][m][n] = (f32x4){0.f, 0.f, 0.f, 0.f};
    bf16x8 At[4][2], B0[2][2], B1[2][2];
    const char* cA = (const char*)g.A + (size_t)cur.pm * tstepA + cur.kofs * 2; const char* cB = (const char*)g.Bt + (size_t)cur.pn * tstepB + cur.kofs * 2;
    if constexpr (SP2) {
        PG8_STAGE(PG8_SB(0, 0), cB, voffB); PG8_STAGE(PG8_SB(0, 1), cB + hstepB, voffB); PG8_STAGE(PG8_SA(0, 0), cA, voffA); PG8_STAGE(PG8_SA(0, 1), cA + hstepA, voffA);
        if (wr == 1) PG8_BAR;
        PG8_WAIT_V(2); PG8_BAR;
        PG8_STAGE(PG8_SB(1, 0), cB + kstep, voffB); PG8_STAGE(PG8_SA(1, 0), cA + kstep, voffA); PG8_STAGE(PG8_SB(1, 1), cB + hstepB + kstep, voffB);
        PG8_WAIT_V(6); PG8_BAR;
    } else {
        PG8_STAGE(PG8_SB(0, 0), cB, voffB); PG8_STAGE(PG8_SA(0, 0), cA, voffA); PG8_STAGE(PG8_SB(0, 1), cB + hstepB, voffB); PG8_STAGE(PG8_SA(0, 1), cA + hstepA, voffA);
        if (wr == 1) PG8_BAR;
        PG8_WAIT_V(4); PG8_BAR;
        PG8_STAGE(PG8_SB(1, 0), cB + kstep, voffB); PG8_STAGE(PG8_SA(1, 0), cA + kstep, voffA); PG8_STAGE(PG8_SB(1, 1), cB + hstepB + kstep, voffB);
        PG8_WAIT_V(6); PG8_BAR;
    }
    for (;;) {
        const bool has_next = S.next(ui + 1, nxt);
        const char* nA = has_next ? (const char*)g.A + (size_t)nxt.pm * tstepA + nxt.kofs * 2 : cA; const char* nB = has_next ? (const char*)g.Bt + (size_t)nxt.pn * tstepB + nxt.kofs * 2 : cB;
        for (int t = 0; t < nt; t += 2) {
            const bool last = (t == nt - 2);
            const char* a1 = cA + (size_t)(t + 1) * kstep;
            const char* a2 = last ? nA : cA + (size_t)(t + 2) * kstep; const char* b2 = last ? nB : cB + (size_t)(t + 2) * kstep;
            const char* a3 = a2 + kstep; const char* b3 = b2 + kstep;
            if constexpr (SP2) {
            PG8_LDB(B0, 0, 0); PG8_LDB(B1, 0, 1); PG8_SCHED; PG8_LDA(At, 0, 0); PG8_STAGE(PG8_SA(1, 1), a1 + hstepA, voffA);
            PG8_WAIT_V(8); PG8_WAIT_L(0); PG8_BAR; PG8_MMA(0, 0, At, B0); PG8_MMA(0, 1, At, B1); PG8_BAR; PG8_SCHED;
            PG8_LDA(At, 0, 1); PG8_STAGE(PG8_SB(0, 0), b2, voffB); PG8_STAGE(PG8_SB(0, 1), b2 + hstepB, voffB); PG8_STAGE(PG8_SA(0, 0), a2, voffA);
            PG8_WAIT_V(8); PG8_WAIT_L(0); PG8_BAR; PG8_MMA(1, 0, At, B0); PG8_MMA(1, 1, At, B1); PG8_BAR; PG8_SCHED;
            PG8_LDB(B0, 1, 0); PG8_LDB(B1, 1, 1); PG8_SCHED; PG8_LDA(At, 1, 0); PG8_STAGE(PG8_SA(0, 1), a2 + hstepA, voffA);
            PG8_WAIT_V(8); PG8_WAIT_L(0); PG8_BAR; PG8_MMA(0, 0, At, B0); PG8_MMA(0, 1, At, B1); PG8_BAR; PG8_SCHED;
            PG8_LDA(At, 1, 1); PG8_STAGE(PG8_SB(1, 0), b3, voffB); PG8_STAGE(PG8_SB(1, 1), b3 + hstepB, voffB); PG8_STAGE(PG8_SA(1, 0), a3, voffA);
            PG8_WAIT_V(8); PG8_WAIT_L(0); PG8_BAR; PG8_MMA(1, 0, At, B0); PG8_MMA(1, 1, At, B1); PG8_BAR; PG8_SCHED;
            } else {
            PG8_LDB(B0, 0, 0); PG8_SCHED; PG8_LDA(At, 0, 0); PG8_STAGE(PG8_SA(1, 1), a1 + hstepA, voffA);
            PG8_WAIT_L(8); PG8_BAR; PG8_WAIT_L(0); PG8_MMA(0, 0, At, B0); PG8_BAR; PG8_SCHED;
            PG8_LDB(B1, 0, 1); PG8_STAGE(PG8_SB(0, 0), b2, voffB);
            PG8_BAR; PG8_WAIT_L(0); PG8_MMA(0, 1, At, B1); PG8_BAR;
            PG8_LDA(At, 0, 1); PG8_STAGE(PG8_SA(0, 0), a2, voffA);
            PG8_BAR; PG8_WAIT_L(0); PG8_MMA(1, 0, At, B0); PG8_BAR; PG8_SCHED;
            PG8_STAGE(PG8_SB(0, 1), b2 + hstepB, voffB);
            PG8_WAIT_V(6); PG8_BAR; PG8_MMA(1, 1, At, B1); PG8_BAR;
            PG8_LDB(B0, 1, 0); PG8_SCHED; PG8_LDA(At, 1, 0); PG8_STAGE(PG8_SA(0, 1), a2 + hstepA, voffA);
            PG8_WAIT_L(8); PG8_BAR; PG8_WAIT_L(0); PG8_MMA(0, 0, At, B0); PG8_BAR; PG8_SCHED;
            PG8_LDB(B1, 1, 1); PG8_STAGE(PG8_SB(1, 0), b3, voffB);
            PG8_BAR; PG8_WAIT_L(0); PG8_MMA(0, 1, At, B1); PG8_BAR;
            PG8_LDA(At, 1, 1); PG8_STAGE(PG8_SA(1, 0), a3, voffA);
            PG8_BAR; PG8_WAIT_L(0); PG8_MMA(1, 0, At, B0); PG8_BAR; PG8_SCHED;
            PG8_STAGE(PG8_SB(1, 1), b3 + hstepB, voffB);
            PG8_WAIT_V(6); PG8_BAR; PG8_MMA(1, 1, At, B1); PG8_BAR;
            }
        }
        if constexpr (ALIGN_EPI) { if (wr == 0) PG8_BAR; }
        bool chained = false;
        if constexpr (Epi::MID) { if (has_next && nxt.pm == cur.pm && nxt.pn == cur.pn) { E.mid(acc, cur, wr, wc, fr, fq); chained = true; } }
        if (!chained) E(acc, cur, wr, wc, fr, fq);
        if (!has_next) break;
        if (!chained) {
#pragma unroll
        for (int a = 0; a < 2; ++a)
#pragma unroll
            for (int b = 0; b < 2; ++b)
#pragma unroll
                for (int m = 0; m < 4; ++m)
#pragma unroll
                    for (int n = 0; n < 2; ++n) acc[a][b][m][n] = (f32x4){0.f, 0.f, 0.f, 0.f};
        }
        cur = nxt; cA = nA; cB = nB; ++ui;
        if constexpr (ALIGN_EPI) { if (wr == 1) PG8_BAR; }
    }
    PG8_WAIT_V(0);
    if constexpr (!ALIGN_EPI) { if (wr == 0) PG8_BAR; }
    PG8_BAR;
#undef PG8_SA
#undef PG8_SB
#undef PG8_STAGE
#undef PG8_LDA
#undef PG8_LDB
#undef PG8_MMA
#undef PG8_WAIT_V
#undef PG8_WAIT_L
#undef PG8_BAR
#undef PG8_SCHED
}

struct EpiBf16 {
    static constexpr bool PERM = true; static constexpr bool MID = false;
    bf16_t* O; int ldc;
    __device__ __forceinline__ void operator()(const f32x4 (&acc)[2][2][4][2], const Unit& u, int wr, int wc, int fr, int fq) const {
        const int row0 = u.pm * BM + wr * 64 + fr, col0 = u.pn * BM + wc * 32 + 8 * fq;
#pragma unroll
        for (int ai = 0; ai < 2; ++ai)
#pragma unroll
            for (int m = 0; m < 4; ++m) { bf16_t* rowp = O + (size_t)(row0 + ai * HALF + m * 16) * ldc + col0;
#pragma unroll
                for (int bj = 0; bj < 2; ++bj) { const f32x4 v0 = acc[ai][bj][m][0], v1 = acc[ai][bj][m][1];
                    u32x4 w; w.x = cvt_pk_bf16(v0[0], v0[1]); w.y = cvt_pk_bf16(v0[2], v0[3]); w.z = cvt_pk_bf16(v1[0], v1[1]); w.w = cvt_pk_bf16(v1[2], v1[3]);
                    *(u32x4*)(rowp + bj * HALF) = w; } }
    }
};
struct EpiInProj {
    static constexpr bool PERM = true; static constexpr bool MID = false;
    bf16_t *Urkv, *Uz, *Usm, *Umg;
    __device__ __forceinline__ void operator()(const f32x4 (&acc)[2][2][4][2], const Unit& u, int wr, int wc, int fr, int fq) const {
        bf16_t* base; int ldc, ct; const int pn = u.pn;
        if (pn < 12) { base = Urkv; ldc = LD_RKV; ct = pn; }
        else if (pn < 20) { if (u.pm >= TX / BM) return; base = Uz; ldc = LD_Z; ct = pn - 12; }
        else if (pn < 25) { base = Usm; ldc = LD_SM; ct = pn - 20; }
        else { if (u.pm >= TX / BM) return; base = Umg; ldc = LD_MG; ct = pn - 25; }
        const bool th = (pn == 23);
        const int row0 = u.pm * BM + wr * 64 + fr, col0 = ct * BM + wc * 32 + 8 * fq;
#pragma unroll
        for (int ai = 0; ai < 2; ++ai)
#pragma unroll
            for (int m = 0; m < 4; ++m) { bf16_t* rowp = base + (size_t)(row0 + ai * HALF + m * 16) * ldc + col0;
#pragma unroll
                for (int bj = 0; bj < 2; ++bj) { f32x4 v0 = acc[ai][bj][m][0], v1 = acc[ai][bj][m][1];
                    if (th && bj == 0) {
#pragma unroll
                        for (int e = 0; e < 4; ++e) { v0[e] = tanhf(v0[e]); v1[e] = tanhf(v1[e]); } }
                    u32x4 w; w.x = cvt_pk_bf16(v0[0], v0[1]); w.y = cvt_pk_bf16(v0[2], v0[3]); w.z = cvt_pk_bf16(v1[0], v1[1]); w.w = cvt_pk_bf16(v1[2], v1[3]);
                    *(u32x4*)(rowp + bj * HALF) = w; } }
    }
};
struct EpiBranchFused {
    static constexpr bool PERM = true, MID = true;
    const bf16_t* mg; bf16_t* Mb;
    __device__ __forceinline__ static float ratio(float a, float b) { a = fminf(fmaxf(a, -80.f), 80.f); b = fminf(fmaxf(b, -80.f), 80.f); return (1.0f + __expf(-b)) * __builtin_amdgcn_rcpf(1.0f + __expf(-a)); }
    __device__ __forceinline__ static float sig(float b) { b = fminf(fmaxf(b, -80.f), 80.f); return __builtin_amdgcn_rcpf(1.0f + __expf(-b)); }
    __device__ __forceinline__ void mid(f32x4 (&acc)[2][2][4][2], const Unit& u, int wr, int wc, int fr, int fq) const {
        const int row0 = u.pm * BM + wr * 64 + fr, col0 = u.pn * BM + wc * 32 + 8 * fq;
#pragma unroll
        for (int ai = 0; ai < 2; ++ai)
#pragma unroll
            for (int m = 0; m < 4; ++m) { const bf16_t* gp = mg + (size_t)(row0 + ai * HALF + m * 16) * LD_MG + col0;
#pragma unroll
                for (int bj = 0; bj < 2; ++bj) { const u32x4 ga = *(const u32x4*)(gp + bj * HALF), gb = *(const u32x4*)(gp + DM + bj * HALF);
                    f32x4& v0 = acc[ai][bj][m][0]; f32x4& v1 = acc[ai][bj][m][1];
                    v0[0] *= ratio(bflo(ga.x), bflo(gb.x)); v0[1] *= ratio(bfhi(ga.x), bfhi(gb.x)); v0[2] *= ratio(bflo(ga.y), bflo(gb.y)); v0[3] *= ratio(bfhi(ga.y), bfhi(gb.y));
                    v1[0] *= ratio(bflo(ga.z), bflo(gb.z)); v1[1] *= ratio(bfhi(ga.z), bfhi(gb.z)); v1[2] *= ratio(bflo(ga.w), bflo(gb.w)); v1[3] *= ratio(bfhi(ga.w), bfhi(gb.w)); } }
    }
    __device__ __forceinline__ void operator()(const f32x4 (&acc)[2][2][4][2], const Unit& u, int wr, int wc, int fr, int fq) const {
        const int row0 = u.pm * BM + wr * 64 + fr, col0 = u.pn * BM + wc * 32 + 8 * fq;
#pragma unroll
        for (int ai = 0; ai < 2; ++ai)
#pragma unroll
            for (int m = 0; m < 4; ++m) { const size_t row = (size_t)(row0 + ai * HALF + m * 16);
#pragma unroll
                for (int bj = 0; bj < 2; ++bj) { const int col = col0 + bj * HALF; const u32x4 gb = *(const u32x4*)(mg + row * LD_MG + DM + col);
                    f32x4 v0 = acc[ai][bj][m][0], v1 = acc[ai][bj][m][1];
                    v0[0] *= sig(bflo(gb.x)); v0[1] *= sig(bfhi(gb.x)); v0[2] *= sig(bflo(gb.y)); v0[3] *= sig(bfhi(gb.y));
                    v1[0] *= sig(bflo(gb.z)); v1[1] *= sig(bfhi(gb.z)); v1[2] *= sig(bflo(gb.w)); v1[3] *= sig(bfhi(gb.w));
                    u32x4 w; w.x = cvt_pk_bf16(v0[0], v0[1]); w.y = cvt_pk_bf16(v0[2], v0[3]); w.z = cvt_pk_bf16(v1[0], v1[1]); w.w = cvt_pk_bf16(v1[2], v1[3]);
                    *(u32x4*)(Mb + row * DM + col) = w; } }
    }
};
struct EpiOut {
    static constexpr bool PERM = false; static constexpr bool MID = false;
    const float* x; const float* mod; float* out;
    __device__ __forceinline__ void operator()(const f32x4 (&acc)[2][2][4][2], const Unit& u, int wr, int wc, int fr, int fq) const {
        const int b = (u.pm * BM) / SEQ; const float* gate = mod + (size_t)b * 6144 + 4096;
        const int col0 = u.pn * BM + wc * 32 + 4 * fq;
        f32x4 gv[2][2];
#pragma unroll
        for (int bj = 0; bj < 2; ++bj)
#pragma unroll
            for (int n = 0; n < 2; ++n) gv[bj][n] = *(const f32x4*)(gate + col0 + bj * HALF + n * 16);
#pragma unroll
        for (int ai = 0; ai < 2; ++ai)
#pragma unroll
            for (int m = 0; m < 4; ++m) { const size_t off = (size_t)(u.pm * BM + ai * HALF + wr * 64 + m * 16 + fr) * DM + col0;
#pragma unroll
                for (int bj = 0; bj < 2; ++bj)
#pragma unroll
                    for (int n = 0; n < 2; ++n) { const f32x4 xs = *(const f32x4*)(x + off + bj * HALF + n * 16);
                        *(f32x4*)(out + off + bj * HALF + n * 16) = xs + gv[bj][n] * acc[ai][bj][m][n]; } }
    }
};
}

namespace att {
constexpr int NW = 8, QBLK = 32, KVBLK = 64;
constexpr float SCALE = 0.07216878364870322f;
constexpr float THR = 8.f;
constexpr int KROW = 384;
constexpr int SHM_V = KVBLK * VH * 2, SHM_K = KVBLK * KROW;
constexpr int NQREG = 8, SHM_QR = NW * (12 - NQREG) * 1024;
constexpr int SHM_ATTN = 2 * SHM_V + 2 * SHM_K + NW * 64 * 4 + SHM_QR;
#define KSWZ(row, colB) ((row) * att::KROW + ((colB) ^ (((row) & 7) << 4)))
#define SBAR() __builtin_amdgcn_sched_barrier(0)
__device__ __forceinline__ int crow(int r, int hi) { return (r & 3) + 8 * (r >> 2) + 4 * hi; }
__device__ __forceinline__ void partialSM(f32x16& p0, f32x16& p1, float& m_reg, float& mn, float& alpha) {
  constexpr float C = SCALE * 1.4426950408889634f;
  float pmax = p0[0];
#pragma unroll
  for (int r = 1; r < 16; ++r) pmax = fmaxf(pmax, p0[r]);
#pragma unroll
  for (int r = 0; r < 16; ++r) pmax = fmaxf(pmax, p1[r]);
  { auto rr = __builtin_amdgcn_permlane32_swap(__float_as_uint(pmax), __float_as_uint(pmax), false, false);
    pmax = fmaxf(__uint_as_float(rr[0]), __uint_as_float(rr[1])); }
  if (__builtin_expect(__all(pmax - m_reg <= THR / SCALE), 1)) { mn = m_reg; alpha = 1.f; }
  else { mn = fmaxf(m_reg, pmax); alpha = __builtin_amdgcn_exp2f((m_reg - mn) * C); m_reg = mn; }
  float mnC = -mn * C;
#pragma unroll
  for (int r = 0; r < 16; ++r) p0[r] = fmaf(p0[r], C, mnC);
#pragma unroll
  for (int r = 0; r < 16; ++r) p1[r] = fmaf(p1[r], C, mnC);
#pragma unroll
  for (int r = 0; r < 16; ++r) p0[r] = __builtin_amdgcn_exp2f(p0[r]);
}
__device__ __forceinline__ void finishSM(f32x16& p0, f32x16& p1, float alpha, float& l_reg, bf16x8& pa0, bf16x8& pa1, bf16x8& pa2, bf16x8& pa3) {
#pragma unroll
  for (int r = 0; r < 16; ++r) p1[r] = __builtin_amdgcn_exp2f(p1[r]);
  float ps = 0;
#pragma unroll
  for (int r = 0; r < 16; ++r) ps += p0[r];
#pragma unroll
  for (int r = 0; r < 16; ++r) ps += p1[r];
  { auto rr = __builtin_amdgcn_permlane32_swap(__float_as_uint(ps), __float_as_uint(ps), false, false);
    ps = __uint_as_float(rr[0]) + __uint_as_float(rr[1]); }
  l_reg = l_reg * alpha + ps;
#define PK4(P, BASE, OUT) do { unsigned a0 = cvt_pk_bf16(P[BASE + 0], P[BASE + 1]), a1 = cvt_pk_bf16(P[BASE + 2], P[BASE + 3]);   \
    unsigned b0 = cvt_pk_bf16(P[BASE + 4], P[BASE + 5]), b1 = cvt_pk_bf16(P[BASE + 6], P[BASE + 7]);                              \
    auto r0 = __builtin_amdgcn_permlane32_swap(a0, b0, false, false); auto r1 = __builtin_amdgcn_permlane32_swap(a1, b1, false, false); \
    u32x4 w = {r0[0], r1[0], r0[1], r1[1]}; OUT = *reinterpret_cast<bf16x8*>(&w); } while (0)
  PK4(p0, 0, pa0); PK4(p0, 8, pa1); PK4(p1, 0, pa2); PK4(p1, 8, pa3);
#undef PK4
}
__device__ __forceinline__ void qkt(f32x16& p0, f32x16& p1, const char* Ks, const bf16x8* qr, const char* qrl, int r32, int hi) {
  p0 = f32x16{}; p1 = f32x16{};
#pragma unroll
  for (int d0 = 0; d0 < 12; ++d0) { const int cb = (d0 * 16 + hi * 8) * 2;
    bf16x8 b0 = *reinterpret_cast<const bf16x8*>(Ks + KSWZ(r32, cb));
    bf16x8 b1 = *reinterpret_cast<const bf16x8*>(Ks + KSWZ(32 + r32, cb));
    const bf16x8 qf = d0 < NQREG ? qr[d0 < NQREG ? d0 : 0] : *reinterpret_cast<const bf16x8*>(qrl + (d0 - NQREG) * 1024);
    p0 = __builtin_amdgcn_mfma_f32_32x32x16_bf16(b0, qf, p0, 0, 0, 0);
    p1 = __builtin_amdgcn_mfma_f32_32x32x16_bf16(b1, qf, p1, 0, 0, 0); }
}
__device__ __forceinline__ int v_st(int k, int c) { const int kk = (k & ~0xC) | ((k & 4) << 1) | ((k & 8) >> 1); return ((kk >> 3) * 4 + (c >> 5)) * 512 + ((kk & 7) * 32 + (c & 31)) * 2; }
__device__ __forceinline__ int v_rd_base(int lane) { return ((lane & 3) << 3) | (((lane >> 2) & 3) << 6) | (((lane >> 4) & 1) << 5) | (((lane >> 5) & 1) << 8); }
constexpr int v_rd_off(int d0, int ks, int half) { return d0 * 512 + ks * 4096 + half * 2048; }
template <int OFF> __device__ __forceinline__ s16x4 tr_read(int vb) {
  s16x4 r; asm volatile("ds_read_b64_tr_b16 %0, %1 offset:%2" : "=&v"(r) : "v"(vb), "i"(OFF) : "memory"); return r;
}
template <int D0> __device__ __forceinline__ void pv_one(f32x16& od, int vb, bf16x8 pa0, bf16x8 pa1, bf16x8 pa2, bf16x8 pa3) {
  const s16x4 l0 = tr_read<v_rd_off(D0, 0, 0)>(vb), h0 = tr_read<v_rd_off(D0, 0, 1)>(vb), l1 = tr_read<v_rd_off(D0, 1, 0)>(vb), h1 = tr_read<v_rd_off(D0, 1, 1)>(vb);
  const s16x4 l2 = tr_read<v_rd_off(D0, 2, 0)>(vb), h2 = tr_read<v_rd_off(D0, 2, 1)>(vb), l3 = tr_read<v_rd_off(D0, 3, 0)>(vb), h3 = tr_read<v_rd_off(D0, 3, 1)>(vb);
  asm volatile("s_waitcnt lgkmcnt(0)" ::: "memory"); SBAR();
#define PK(L, H) (bf16x8){L[0], L[1], L[2], L[3], H[0], H[1], H[2], H[3]}
  od = __builtin_amdgcn_mfma_f32_32x32x16_bf16(pa0, PK(l0, h0), od, 0, 0, 0);
  od = __builtin_amdgcn_mfma_f32_32x32x16_bf16(pa1, PK(l1, h1), od, 0, 0, 0);
  od = __builtin_amdgcn_mfma_f32_32x32x16_bf16(pa2, PK(l2, h2), od, 0, 0, 0);
  od = __builtin_amdgcn_mfma_f32_32x32x16_bf16(pa3, PK(l3, h3), od, 0, 0, 0);
#undef PK
}
__device__ __forceinline__ void pv_d0(f32x16* o, int vb, bf16x8 pa0, bf16x8 pa1, bf16x8 pa2, bf16x8 pa3) {
  pv_one<0>(o[0], vb, pa0, pa1, pa2, pa3); pv_one<1>(o[1], vb, pa0, pa1, pa2, pa3); pv_one<2>(o[2], vb, pa0, pa1, pa2, pa3); pv_one<3>(o[3], vb, pa0, pa1, pa2, pa3);
}

__device__ __forceinline__ void attn_unit(int b, int h, int qb, const bf16_t* __restrict__ Q, const bf16_t* __restrict__ KV, const bf16_t* __restrict__ KR,
                                          const bf16_t* __restrict__ Uz, bf16_t* __restrict__ Oml, char* lds) {
  const int tid = threadIdx.x, wid = tid >> 6, lane = tid & 63, r32 = lane & 31, hi = lane >> 5;
  char* V_lds = lds; char* K_lds = lds + 2 * SHM_V;
  float* ws = (float*)(lds + 2 * SHM_V + 2 * SHM_K) + wid * 64; float* li_l = ws; float* al_l = ws + 32;
  float m_reg = -1e30f, l_reg = 0; f32x16 o[4] = {}; bf16x8 qr[NQREG];
  char* qrl = lds + 2 * SHM_V + 2 * SHM_K + NW * 64 * 4 + wid * ((12 - NQREG) * 1024) + lane * 16;
  const long qrow0 = (long)b * SEQ + (long)qb * 256;
  const bf16_t* Qw = Q + (qrow0 + wid * QBLK + r32) * LD_Q + h * QKD + hi * 8;
#pragma unroll
  for (int d0 = 0; d0 < NQREG; ++d0) qr[d0] = *reinterpret_cast<const bf16x8*>(Qw + d0 * 16);
#pragma unroll
  for (int d0 = NQREG; d0 < 12; ++d0) *reinterpret_cast<bf16x8*>(qrl + (d0 - NQREG) * 1024) = *reinterpret_cast<const bf16x8*>(Qw + d0 * 16);
  const int sr = tid >> 4, sc = (tid & 15) * 8, vst0 = v_st(sr, sc), vst1 = v_st(32 + sr, sc);
  const int rr_ = tid >> 3, rc_ = (tid & 7) * 8;
  const int vb0 = (int)(uintptr_t)V_lds + v_rd_base(lane);
  const unsigned offk = (unsigned)((sr * LD_KV + h * 256 + sc) * 2), offr = (unsigned)((rr_ * LD_KR + h * 64 + rc_) * 2);
  struct { bf16x8 vs0, vs1, ks0, ks1, kr; } sr_[1];
#define TROW(t) ((t) < 128 ? (long)b * SEQ + (long)(t) * KVBLK : (long)TX + (long)b * CTXL + (long)((t) - 128) * KVBLK)
#define SLOAD(i, t) do { const char* kvt_ = (const char*)KV + (size_t)TROW(t) * (LD_KV * 2); const char* krt_ = (const char*)KR + (size_t)TROW(t) * (LD_KR * 2); \
    sr_[i].vs0 = *reinterpret_cast<const bf16x8*>(kvt_ + offk + 256u); sr_[i].vs1 = *reinterpret_cast<const bf16x8*>(kvt_ + offk + (unsigned)(32 * LD_KV * 2 + 256)); \
    sr_[i].ks0 = *reinterpret_cast<const bf16x8*>(kvt_ + offk); sr_[i].ks1 = *reinterpret_cast<const bf16x8*>(kvt_ + offk + (unsigned)(32 * LD_KV * 2)); \
    sr_[i].kr = *reinterpret_cast<const bf16x8*>(krt_ + offr); } while (0)
#define SWRITE(bb, i) do { *(bf16x8*)(V_lds + (bb) * SHM_V + vst0) = sr_[i].vs0;          \
    *(bf16x8*)(V_lds + (bb) * SHM_V + vst1) = sr_[i].vs1; const int kc = sc * 2;               \
    *(bf16x8*)(K_lds + (bb) * SHM_K + KSWZ(sr, kc)) = sr_[i].ks0;                       \
    *(bf16x8*)(K_lds + (bb) * SHM_K + KSWZ(32 + sr, kc)) = sr_[i].ks1;                  \
    *(bf16x8*)(K_lds + (bb) * SHM_K + KSWZ(rr_, 256 + rc_ * 2)) = sr_[i].kr; } while (0)
#define SWAIT() asm volatile("s_waitcnt vmcnt(0)" ::: "memory")
#define RESC(a) do { if (__any((a) < 1.f)) { if (hi == 0) al_l[r32] = (a); asm volatile("s_waitcnt lgkmcnt(0)" ::: "memory"); \
    _Pragma("unroll") for (int d = 0; d < 4; ++d) _Pragma("unroll") for (int r = 0; r < 16; ++r) o[d][r] *= al_l[crow(r, hi)]; } } while (0)
  f32x16 pA0, pA1, pB0, pB1; float mnA, mnB, alA, alB; bf16x8 pa0, pa1, pa2, pa3; constexpr int NT = (SEQ + CTXL) / KVBLK;
  constexpr int SE = 0, SO = 0;
  SLOAD(SE, 0); asm volatile("s_waitcnt vmcnt(0)" ::: "memory"); SWRITE(0, SE); __syncthreads();
  qkt(pA0, pA1, K_lds, qr, qrl, r32, hi); partialSM(pA0, pA1, m_reg, mnA, alA);
  SLOAD(SO, 1);
  SWAIT(); SWRITE(1, SO); __syncthreads();
  for (int j = 1; j + 1 < NT; j += 2) {
    SBAR(); qkt(pB0, pB1, K_lds + SHM_K, qr, qrl, r32, hi);
    finishSM(pA0, pA1, alA, l_reg, pa0, pa1, pa2, pa3); SBAR();
    SLOAD(SO, j + 1); SBAR();
    pv_d0(o, vb0, pa0, pa1, pa2, pa3); partialSM(pB0, pB1, m_reg, mnB, alB);
    __syncthreads(); SWAIT(); SWRITE(0, SE);
    RESC(alB); __syncthreads();
    SBAR(); qkt(pA0, pA1, K_lds, qr, qrl, r32, hi);
    finishSM(pB0, pB1, alB, l_reg, pa0, pa1, pa2, pa3); SBAR();
    SLOAD(SE, j + 2); SBAR();
    pv_d0(o, vb0 + SHM_V, pa0, pa1, pa2, pa3); partialSM(pA0, pA1, m_reg, mnA, alA);
    __syncthreads(); SWAIT(); SWRITE(1, SO);
    RESC(alA); __syncthreads();
  }
  SBAR(); qkt(pB0, pB1, K_lds + SHM_K, qr, qrl, r32, hi);
  finishSM(pA0, pA1, alA, l_reg, pa0, pa1, pa2, pa3); SBAR();
  pv_d0(o, vb0, pa0, pa1, pa2, pa3); partialSM(pB0, pB1, m_reg, mnB, alB);
  __syncthreads(); RESC(alB);
  finishSM(pB0, pB1, alB, l_reg, pa0, pa1, pa2, pa3); SBAR();
  pv_d0(o, vb0 + SHM_V, pa0, pa1, pa2, pa3);
  if (hi == 0) li_l[r32] = l_reg; asm volatile("s_waitcnt lgkmcnt(0)" ::: "memory");
  float rli[16];
#pragma unroll
  for (int r = 0; r < 16; ++r) rli[r] = __builtin_amdgcn_rcpf(li_l[crow(r, hi)]);
  const long orow0 = qrow0 + wid * QBLK;
#pragma unroll
  for (int r = 0; r < 16; ++r) { const long row = orow0 + crow(r, hi);
#pragma unroll
    for (int d0 = 0; d0 < 4; ++d0) { const int col = h * VH + d0 * 32 + r32;
      const float z = bf2f(Oml[row * LD_Z + col]);
      Oml[row * LD_Z + col] = (bf16_t)f2bf(o[d0][r] * rli[r] * siluf_(z)); } }
  __syncthreads();
#undef TROW
#undef SLOAD
#undef SWRITE
#undef SWAIT
#undef RESC
}
#undef SBAR
}

constexpr int NWAVES = 8, NTHREADS = 512;
constexpr int LDS_BYTES = 147456;
struct Args { const float* in[27]; float* out; unsigned char* ws; int ph_lo, ph_hi; };


__device__ __forceinline__ const float* kin(int i) {
    unsigned long long v; const unsigned long long ka = (unsigned long long)__builtin_amdgcn_kernarg_segment_ptr();
    asm volatile("s_load_dwordx2 %0, %1, %2\n\ts_waitcnt lgkmcnt(0)" : "=s"(v) : "s"(ka), "n"(i * 8) : "memory");
    return (const float*)(const __attribute__((address_space(1))) float*)v;
}

__device__ __forceinline__ void tr_item(const float* __restrict__ W, int ldw, int k0, int n0, bf16_t* __restrict__ WT, int ldd, int drow0, int dcol0,
                                        const float* __restrict__ ksc, LAS float* scr, int lane) {
    float wv[32];
#pragma unroll
    for (int i = 0; i < 32; ++i) wv[i] = W[(size_t)(k0 + 2 * i + (lane >> 5)) * ldw + n0 + (lane & 31)];
#pragma unroll
    for (int i = 0; i < 32; ++i) { const int kk = 2 * i + (lane >> 5); float v = wv[i]; if (ksc) v *= ksc[k0 + kk]; scr[kk * 33 + (lane & 31)] = v; }
    LDS_WAIT(); asm volatile("" ::: "memory");
    const int c = lane & 7;
#pragma unroll
    for (int j = 0; j < 4; ++j) { const int n = (lane >> 3) + 8 * j; const LAS float* s = scr + (8 * c) * 33 + n;
        u32x4 o; o.x = pk2(s[0 * 33], s[1 * 33]); o.y = pk2(s[2 * 33], s[3 * 33]); o.z = pk2(s[4 * 33], s[5 * 33]); o.w = pk2(s[6 * 33], s[7 * 33]);
        *(u32x4*)(WT + (size_t)(drow0 + n) * ldd + dcol0 + k0 + 8 * c) = o; }
    LDS_WAIT(); asm volatile("" ::: "memory");
}
__device__ __forceinline__ int inproj_dst(int n) {
    if (n < 3072) return n;
    if (n < 4096) return n;
    if (n < 4224) return 5888 + (n - 4096);
    if (n < 4352) return 6016 + (n - 4224);
    if (n < 4864) return 5120 + (n - 4352);
    if (n < 5120) return 5632 + (n - 4864);
    if (n < 5184) return 6144 + (n - 5120);
    if (n < 6208) return 4096 + (n - 5184);
    return 6400 + (n - 6208);
}
template <bool LATE> __device__ __forceinline__ void p0_weights(const Args& a, LAS unsigned char* lds, int gw, int NGW, int wave, int lane) {
    LAS float* scr = (LAS float*)(lds + wave * 16384);
    unsigned char* ws = a.ws;
    constexpr int I_IN = 32 * 322, I_PAD = 192, I_UQ = 8 * 48, I_UKV = 4 * 64, I_BR = 16 * 64, I_OUT = 32 * 64, I_LORA = 128;
    constexpr int NITEMS = I_IN + I_PAD + I_UQ + I_UKV + 2 * I_BR + I_OUT + I_LORA;
    constexpr int N_EARLY = I_IN + I_PAD + I_LORA, N_LATE = I_UQ + I_UKV + 2 * I_BR + I_OUT;
    for (int it = gw; it < (LATE ? N_LATE : N_EARLY); it += NGW) {
        int r = LATE ? it + I_IN + I_PAD : (it < I_IN + I_PAD ? it : it + N_LATE);
        if (r < I_IN) { const int kb = r / 322, nb = r % 322; tr_item(kin(7), 10304, 64 * kb, 32 * nb, (bf16_t*)(ws + WS_WIN), DM, inproj_dst(32 * nb), 0, nullptr, scr, lane); continue; } r -= I_IN;
        if (r < I_PAD) {
            const int kb = r / 6, nb = r % 6; bf16_t* d = (bf16_t*)(ws + WS_WIN) + (size_t)(6208 + 32 * nb) * DM + 64 * kb;
#pragma unroll
            for (int j = 0; j < 4; ++j) { const int n = (lane >> 3) + 8 * j; *(u32x4*)(d + (size_t)n * DM + 8 * (lane & 7)) = (u32x4){0u, 0u, 0u, 0u}; }
            continue; } r -= I_PAD;
        if (r < I_UQ) { const int kb = r / 48, nb = r % 48; tr_item(kin(19), 1536, 64 * kb, 32 * nb, (bf16_t*)(ws + WS_WUQ), 512, 32 * nb, 0, kin(18), scr, lane); continue; } r -= I_UQ;
        if (r < I_UKV) { const int kb = r / 64, nb = r % 64; tr_item(kin(21), 2048, 64 * kb, 32 * nb, (bf16_t*)(ws + WS_WUKV), 256, 32 * nb, 0, kin(20), scr, lane); continue; } r -= I_UKV;
        if (r < I_BR) { const int kb = r / 64, nb = r % 64; tr_item(kin(24), 2048, 64 * kb, 32 * nb, (bf16_t*)(ws + WS_WBR), 2048, 32 * nb, 0, nullptr, scr, lane); continue; } r -= I_BR;
        if (r < I_BR) { const int kb = r / 64, nb = r % 64; tr_item(kin(25), 2048, 64 * kb, 32 * nb, (bf16_t*)(ws + WS_WBR), 2048, 32 * nb, 1024, nullptr, scr, lane); continue; } r -= I_BR;
        if (r < I_OUT) { const int kb = r / 64, nb = r % 64; tr_item(kin(26), 2048, 64 * kb, 32 * nb, (bf16_t*)(ws + WS_WOUT), 2048, 32 * nb, 0, nullptr, scr, lane); continue; } r -= I_OUT;
        {
            const int g = r / 32, nb = r % 32; const float* src = (g < 2 ? kin(10) : kin(12)) + (size_t)(g & 1) * 64 * 1024;
            bf16_t* WT = (bf16_t*)(ws + WS_WLORA);
            for (int q = lane; q < 768; q += 64) { const int n = q / 24, ch = q % 24, kc = (ch < g * 8) ? ch : ch + 8;
                *(u32x4*)(WT + (size_t)(g * 1024 + 32 * nb + n) * 256 + kc * 8) = (u32x4){0u, 0u, 0u, 0u}; }
            tr_item(src, 1024, 0, 32 * nb, WT, 256, g * 1024 + 32 * nb, g * 64, nullptr, scr, lane);
        }
    }
}
__device__ __forceinline__ void p0_mod(const Args& a, LAS unsigned char* lds, int vb, int tid) {
    if (vb >= 192) return;
    const float* c = kin(1); const float* cc = kin(3); const float* wm = kin(5); const float* bm = kin(6);
    float* mod = (float*)(a.ws + WS_MOD);
    const int n0 = vb * 32, g = tid & 7, ks = tid >> 3;
    f32x4 acc0 = {0, 0, 0, 0}, acc1 = {0, 0, 0, 0}, acc2 = {0, 0, 0, 0};
#pragma unroll 8
    for (int i = 0; i < 32; ++i) { const int k = ks * 32 + i;
        const f32x4 w = *(const f32x4*)(wm + (size_t)k * 6144 + n0 + 4 * g);
        const float s0 = siluf_(c[k]), s1 = siluf_(c[2048 + k]), s2 = siluf_(cc[k]);
        acc0 += w * s0; acc1 += w * s1; acc2 += w * s2; }
    LAS float* red = (LAS float*)lds;
    *(LAS f32x4*)(red + (ks * 3 + 0) * 32 + 4 * g) = acc0; *(LAS f32x4*)(red + (ks * 3 + 1) * 32 + 4 * g) = acc1; *(LAS f32x4*)(red + (ks * 3 + 2) * 32 + 4 * g) = acc2;
    __syncthreads();
    if (tid < 96) { const int v = tid >> 5, col = tid & 31; float s = 0.f;
        for (int k = 0; k < 64; ++k) s += red[(k * 3 + v) * 32 + col];
        mod[v * 6144 + n0 + col] = s + bm[n0 + col]; }
    __syncthreads();
}
__device__ __forceinline__ void p1_hm(const Args& a, LAS unsigned char* lds, int gw, int NGW, int lane) {
    const float* nw = kin(4); const float* mod = (const float*)(a.ws + WS_MOD); bf16_t* hm = (bf16_t*)(a.ws + WS_HM);
    LAS float* tab = (LAS float*)lds; const float* xin = kin(0); const float* cin_ = kin(2);
    for (int i = threadIdx.x; i < 3 * 2048; i += NTHREADS) { const int v = i >> 11, c = i & 2047; tab[(v * 2) * 2048 + c] = nw[c] * (1.0f + mod[v * 6144 + 2048 + c]); tab[(v * 2 + 1) * 2048 + c] = mod[v * 6144 + c]; }
    __syncthreads();
    for (int m = gw; m < TT; m += NGW) {
        const float* xr; int v;
        if (m < TX) { xr = xin + (size_t)m * DM; v = m / SEQ; } else { xr = cin_ + (size_t)(m - TX) * DM; v = 2; }
        f32x4 xv[8]; float ss = 0.f;
#pragma unroll
        for (int j = 0; j < 8; ++j) { xv[j] = *(const f32x4*)(xr + 4 * (lane + 64 * j)); ss += (xv[j][0] * xv[j][0] + xv[j][1] * xv[j][1]) + (xv[j][2] * xv[j][2] + xv[j][3] * xv[j][3]); }
        const float rstd = rsqrtf(wave_sum(ss) * (1.f / DM) + EPS);
#pragma unroll
        for (int j = 0; j < 8; ++j) { const int c0 = 4 * (lane + 64 * j);
            const f32x4 gn = *(const LAS f32x4*)(tab + (v * 2) * 2048 + c0), sh = *(const LAS f32x4*)(tab + (v * 2 + 1) * 2048 + c0);
            const f32x4 y = (xv[j] * rstd) * gn + sh;
            u32x2 o; o.x = cvt_pk_bf16(y[0], y[1]); o.y = cvt_pk_bf16(y[2], y[3]);
            *(u32x2*)(hm + (size_t)m * DM + c0) = o; }
    }
}

__device__ __forceinline__ void unpack8(const u32x4 w, float* f) { f[0] = bflo(w.x); f[1] = bfhi(w.x); f[2] = bflo(w.y); f[3] = bfhi(w.y); f[4] = bflo(w.z); f[5] = bfhi(w.z); f[6] = bflo(w.w); f[7] = bfhi(w.w); }
__device__ __forceinline__ u32x4 pack8(const float* f) { u32x4 w; w.x = pk2(f[0], f[1]); w.y = pk2(f[2], f[3]); w.z = pk2(f[4], f[5]); w.w = pk2(f[6], f[7]); return w; }
__device__ __forceinline__ u32x4 pack8c(const float* f) { u32x4 w; w.x = cvt_pk_bf16(f[0], f[1]); w.y = cvt_pk_bf16(f[2], f[3]); w.z = cvt_pk_bf16(f[4], f[5]); w.w = cvt_pk_bf16(f[6], f[7]); return w; }
__device__ __forceinline__ float sum8sq(const float* f) { return ((f[0] * f[0] + f[1] * f[1]) + (f[2] * f[2] + f[3] * f[3])) + ((f[4] * f[4] + f[5] * f[5]) + (f[6] * f[6] + f[7] * f[7])); }
__device__ __forceinline__ float red8(float v) { v += __shfl_xor(v, 1); v += __shfl_xor(v, 2); v += __shfl_xor(v, 4); return v; }

namespace cs {
constexpr int RS = 144, SLOT = 64 * RS, NCHUNK = 132, NSEG = 4, CPS = NCHUNK / NSEG;
enum { S_KKD = 0, S_RD = 1, S_KINV = 2, S_AKINV = 3, S_NAKBT = 4, S_KKDT = 5, S_KBART = 6, S_VT = 7, S_AAKT = 8, S_AQK = 9, S_NAQA = 10, S_N = 11, S_NT = 12, S_F2 = 13, S_ST = 14,
       S_NB = 0, S_NBT = 2, S_F1 = 3, S_G1 = 11, S_G2 = 12, S_P = 0, S_RW = 2, S_M2 = 13, S_M4 = 3, S_PACC = 9 };
constexpr int OFF_WTOT = 15 * SLOT, OFF_GC = OFF_WTOT + 8 * 64 * 4, OFF_RN = OFF_GC + 256, OFF_LWW = S_N * SLOT, OFF_LWA = S_KKD * SLOT, OFF_RED1 = S_KINV * SLOT, OFF_RED2 = S_NAKBT * SLOT;
static_assert(OFF_RN + 8 * 8 * 4 <= 147456 - 256, "chunk scan LDS map");
#define CS_AR(s) (lds + (s) * cs::SLOT)
#define CS_BAR() asm volatile("s_waitcnt lgkmcnt(0)\n\ts_barrier" ::: "memory")

template <int KS0, int KS1> __device__ __forceinline__ f32x16 tile_nt(f32x16 acc, const LAS unsigned char* X, int m0, const LAS unsigned char* Y, int n0, int r32, int hi) {
#pragma unroll
    for (int ks = KS0; ks < KS1; ++ks) {
        const bf16x8 a = *(const LAS bf16x8*)(X + (m0 + r32) * RS + ks * 32 + hi * 16);
        const bf16x8 b = *(const LAS bf16x8*)(Y + (n0 + r32) * RS + ks * 32 + hi * 16);
        acc = __builtin_amdgcn_mfma_f32_32x32x16_bf16(a, b, acc, 0, 0, 0);
    }
    return acc;
}
__device__ __forceinline__ f32x16 tile_rng(int range, f32x16 acc, const LAS unsigned char* X, int m0, const LAS unsigned char* Y, int n0, int r32, int hi) {
    if (range == 0) return tile_nt<0, 4>(acc, X, m0, Y, n0, r32, hi);
    if (range == 1) return tile_nt<0, 2>(acc, X, m0, Y, n0, r32, hi);
    return tile_nt<2, 4>(acc, X, m0, Y, n0, r32, hi);
}
__device__ __forceinline__ void tile2_nt(f32x16& a0, const LAS unsigned char* X0, int m00, const LAS unsigned char* Y0, int n00, f32x16& a1, const LAS unsigned char* X1, int m01, const LAS unsigned char* Y1, int n01, int r32, int hi) {
#pragma unroll
    for (int ks = 0; ks < 4; ++ks) {
        const bf16x8 xa = *(const LAS bf16x8*)(X0 + (m00 + r32) * RS + ks * 32 + hi * 16), ya = *(const LAS bf16x8*)(Y0 + (n00 + r32) * RS + ks * 32 + hi * 16);
        const bf16x8 xb = *(const LAS bf16x8*)(X1 + (m01 + r32) * RS + ks * 32 + hi * 16), yb = *(const LAS bf16x8*)(Y1 + (n01 + r32) * RS + ks * 32 + hi * 16);
        a0 = __builtin_amdgcn_mfma_f32_32x32x16_bf16(xa, ya, a0, 0, 0, 0); a1 = __builtin_amdgcn_mfma_f32_32x32x16_bf16(xb, yb, a1, 0, 0, 0);
    }
}
__device__ __forceinline__ void tile3_nt(f32x16& a0, const LAS unsigned char* X0, const LAS unsigned char* Y0, f32x16& a1, const LAS unsigned char* X1, const LAS unsigned char* Y1,
                                         f32x16& a2, const LAS unsigned char* X2, const LAS unsigned char* Y2, int m0, int n0, int r32, int hi) {
#pragma unroll
    for (int ks = 0; ks < 4; ++ks) { const int xo = (m0 + r32) * RS + ks * 32 + hi * 16, yo = (n0 + r32) * RS + ks * 32 + hi * 16;
        a0 = __builtin_amdgcn_mfma_f32_32x32x16_bf16(*(const LAS bf16x8*)(X0 + xo), *(const LAS bf16x8*)(Y0 + yo), a0, 0, 0, 0);
        a1 = __builtin_amdgcn_mfma_f32_32x32x16_bf16(*(const LAS bf16x8*)(X1 + xo), *(const LAS bf16x8*)(Y1 + yo), a1, 0, 0, 0);
        a2 = __builtin_amdgcn_mfma_f32_32x32x16_bf16(*(const LAS bf16x8*)(X2 + xo), *(const LAS bf16x8*)(Y2 + yo), a2, 0, 0, 0); }
}
__device__ __forceinline__ void tile_diag_pair(f32x16& a0, f32x16& a1, const LAS unsigned char* X, const LAS unsigned char* Y, int r32, int hi) {
#pragma unroll
    for (int ks = 0; ks < 2; ++ks) {
        a0 = __builtin_amdgcn_mfma_f32_32x32x16_bf16(*(const LAS bf16x8*)(X + r32 * RS + ks * 32 + hi * 16), *(const LAS bf16x8*)(Y + r32 * RS + ks * 32 + hi * 16), a0, 0, 0, 0);
        a1 = __builtin_amdgcn_mfma_f32_32x32x16_bf16(*(const LAS bf16x8*)(X + (32 + r32) * RS + (ks + 2) * 32 + hi * 16), *(const LAS bf16x8*)(Y + (32 + r32) * RS + (ks + 2) * 32 + hi * 16), a1, 0, 0, 0);
    }
}
__device__ __forceinline__ void store_nat(LAS unsigned char* E, int m0, int n0, const f32x16& d, int r32, int hi) {
#pragma unroll
    for (int g = 0; g < 4; ++g) { u32x2 w; w.x = cvt_pk_bf16(d[4 * g], d[4 * g + 1]); w.y = cvt_pk_bf16(d[4 * g + 2], d[4 * g + 3]);
        *(LAS u32x2*)(E + (n0 + r32) * RS + (m0 + 8 * g + 4 * hi) * 2) = w; }
}
__device__ __forceinline__ void store_nat_g(bf16_t* E, int m0, int n0, const f32x16& d, int r32, int hi) {
#pragma unroll
    for (int g = 0; g < 4; ++g) { u32x2 w; w.x = cvt_pk_bf16(d[4 * g], d[4 * g + 1]); w.y = cvt_pk_bf16(d[4 * g + 2], d[4 * g + 3]);
        *(u32x2*)(E + (n0 + r32) * 64 + (m0 + 8 * g + 4 * hi)) = w; }
}
__device__ __forceinline__ void store_zero(LAS unsigned char* E, int m0, int n0, int r32, int hi) {
#pragma unroll
    for (int g = 0; g < 4; ++g) *(LAS u32x2*)(E + (n0 + r32) * RS + (m0 + 8 * g + 4 * hi) * 2) = (u32x2){0u, 0u};
}
__device__ __forceinline__ void add_nat(f32x16& d, const LAS unsigned char* E, int m0, int n0, int r32, int hi) {
#pragma unroll
    for (int g = 0; g < 4; ++g) { const u32x2 w = *(const LAS u32x2*)(E + (n0 + r32) * RS + (m0 + 8 * g + 4 * hi) * 2);
        d[4 * g] += bflo(w.x); d[4 * g + 1] += bfhi(w.x); d[4 * g + 2] += bflo(w.y); d[4 * g + 3] += bfhi(w.y); }
}
template <int MODE, bool NEG> __device__ __forceinline__ void mask_tile(f32x16& d, int m0, int n0, int r32, int hi) {
    const int n = n0 + r32;
#pragma unroll
    for (int r = 0; r < 16; ++r) { const int m = m0 + (r & 3) + 8 * (r >> 2) + 4 * hi;
        const bool keep = MODE == 0 ? (n < m) : (MODE == 1 ? (m <= n) : (m < n));
        d[r] = keep ? (NEG ? -d[r] : d[r]) : 0.f; }
}
template <int CTRL> __device__ __forceinline__ float dpp_addf(float v) { return v + __int_as_float(__builtin_amdgcn_update_dpp(0, __float_as_int(v), CTRL, 0xF, 0xF, true)); }
__device__ __forceinline__ float sum_oct(float v) { v = dpp_addf<0xB1>(v); v = dpp_addf<0x4E>(v); v = dpp_addf<0x141>(v); return v; }

__device__ __forceinline__ void g2l(LAS unsigned char* slot, const bf16_t* g, int tid) { *(LAS u32x4*)(slot + (tid >> 3) * RS + (tid & 7) * 16) = *(const u32x4*)(g + (tid >> 3) * 64 + (tid & 7) * 8); }
__device__ __forceinline__ void l2g(bf16_t* g, const LAS unsigned char* slot, int tid) { *(u32x4*)(g + (tid >> 3) * 64 + (tid & 7) * 8) = *(const LAS u32x4*)(slot + (tid >> 3) * RS + (tid & 7) * 16); }

struct Chain { int d, b, h; };
struct ChainConst { float cw[3][3], w0c, a0c, kkc, kac, rkc; bf16x8 wl[4]; };
struct Prefetch { u32x4 xq[4]; bf16x8 lx[4]; };
__device__ __forceinline__ int tok_row(const Chain& ch, int c, int t) {
    const int s = c * 64 + t;
    if (s < CTXL) return TX + ch.b * CTXL + (ch.d ? (CTXL - 1 - s) : s);
    const int u = s - CTXL; return ch.b * SEQ + (ch.d ? (SEQ - 1 - u) : u);
}
__device__ __forceinline__ void wave_geom(const Chain& ch, int c, int wave, int& rowbase, int& seqlen, int& tmin) {
    const int s0 = c * 64 + wave * 8; int tfirst;
    if (s0 < CTXL) { seqlen = CTXL; rowbase = TX + ch.b * CTXL; tfirst = ch.d ? (CTXL - 1 - s0) : s0; }
    else { const int u = s0 - CTXL; seqlen = SEQ; rowbase = ch.b * SEQ; tfirst = ch.d ? (SEQ - 1 - u) : u; }
    tmin = ch.d ? tfirst - 7 : tfirst;
}
__device__ __forceinline__ void pf_issue(Prefetch& pf, unsigned char* ws, const Chain& ch, int c, int wave, int lane) {
    const bf16_t* Urkv = (const bf16_t*)(ws + WS_URKV); const bf16_t* Usm = (const bf16_t*)(ws + WS_USM);
    int rowbase, seqlen, tmin; wave_geom(ch, c, wave, rowbase, seqlen, tmin);
#pragma unroll
    for (int k = 0; k < 4; ++k) { const int q = lane + 64 * k, i = q / 24, rem = q - 24 * i, e = rem >> 3, c8 = rem & 7;
        const int t = tmin - 1 + i; const bool ok = (t >= 0) && (t < seqlen);
        if (q < 240) pf.xq[k] = *(const u32x4*)(Urkv + (size_t)(rowbase + (ok ? t : tmin)) * LD_RKV + e * 1024 + ch.h * 64 + c8 * 8); }
    const int type = wave >> 2, mi = (wave >> 1) & 1, r32 = lane & 31, hi = lane >> 5;
    const bf16_t* xp = Usm + (size_t)tok_row(ch, c, 32 * mi + r32) * LD_SM + 768 + type * 128 + ch.d * 64 + hi * 8;
#pragma unroll
    for (int ks = 0; ks < 4; ++ks) pf.lx[ks] = *(const bf16x8*)(xp + ks * 16);
}

__device__ __forceinline__ void chunk(LAS unsigned char* lds, unsigned char* ws, const Chain ch, const ChainConst& cc, Prefetch& pf, int c, int c_end, int tid, int wave_, int lane_) {
    constexpr bool PASSB = true;
    int wave = wave_, lane = lane_; asm volatile("" : "+v"(wave), "+v"(lane));
    const int r32 = lane & 31, hi = lane >> 5;
    const bool latent = c >= CTXL / 64;
    {
        const int type = wave >> 2, mi = (wave >> 1) & 1, ni = wave & 1;
        f32x16 acc = {};
#pragma unroll
        for (int ks = 0; ks < 4; ++ks) acc = __builtin_amdgcn_mfma_f32_32x32x16_bf16(pf.lx[ks], cc.wl[ks], acc, 0, 0, 0);
        LAS float* o = (LAS float*)(lds + (type ? OFF_LWA : OFF_LWW));
#pragma unroll
        for (int r = 0; r < 16; ++r) o[(32 * mi + (r & 3) + 8 * (r >> 2) + 4 * hi) * 64 + 32 * ni + r32] = acc[r];
    }
    float rr[8], kkv[8], kmv[8], akv[8], vv[8], lgw[8], cum[8];
    int rowbase, seqlen, tmin; wave_geom(ch, c, wave, rowbase, seqlen, tmin);
    {
        LAS float* red1 = (LAS float*)(lds + OFF_RED1) + wave * 512; LAS float* red2 = (LAS float*)(lds + OFF_RED2) + wave * 512;
        LAS unsigned char* stg = lds + S_KBART * SLOT + wave * 3840;
#pragma unroll
        for (int k = 0; k < 4; ++k) if (lane + 64 * k < 240) *(LAS u32x4*)(stg + (lane + 64 * k) * 16) = pf.xq[k];
        asm volatile("s_waitcnt lgkmcnt(0)" ::: "memory");
        float x[10][3];
#pragma unroll
        for (int i = 0; i < 10; ++i)
#pragma unroll
            for (int e = 0; e < 3; ++e) x[i][e] = bf2f(*(const LAS bf16_t*)(stg + ((i * 3 + e) * 64 + lane) * 2));
        if (tmin == 0) { x[0][0] = 0.f; x[0][1] = 0.f; x[0][2] = 0.f; }
        if (tmin + 8 == seqlen) { x[9][0] = 0.f; x[9][1] = 0.f; x[9][2] = 0.f; }
#pragma unroll
        for (int jj = 0; jj < 8; ++jj) {
            rr[jj] = cc.cw[0][0] * x[jj][0] + cc.cw[1][0] * x[jj + 1][0] + cc.cw[2][0] * x[jj + 2][0];
            const float k = cc.cw[0][1] * x[jj][1] + cc.cw[1][1] * x[jj + 1][1] + cc.cw[2][1] * x[jj + 2][1];
            vv[jj] = cc.cw[0][2] * x[jj][2] + cc.cw[1][2] * x[jj + 1][2] + cc.cw[2][2] * x[jj + 2][2];
            kmv[jj] = k; kkv[jj] = k * cc.kkc; red1[jj * 64 + lane] = kkv[jj] * kkv[jj];
        }
        CS_BAR();
        const LAS float* lww = (const LAS float*)(lds + OFF_LWW); const LAS float* lwa = (const LAS float*)(lds + OFF_LWA);
#pragma unroll
        for (int jj = 0; jj < 8; ++jj) {
            const int tl = wave * 8 + (ch.d ? 7 - jj : jj);
            lgw[jj] = -0.6065306597126334f * fast_sigmoid(cc.w0c + lww[tl * 64 + lane]);
            const float a = fast_sigmoid(cc.a0c + lwa[tl * 64 + lane]);
            const float k = kmv[jj]; kmv[jj] = k * (1.0f + (a - 1.0f) * cc.kac); akv[jj] = a * kkv[jj];
            if (PASSB) red2[jj * 64 + lane] = rr[jj] * kmv[jj] * cc.rkc;
        }
        asm volatile("s_waitcnt lgkmcnt(0)" ::: "memory");
        { const int tk = lane >> 3, cg = lane & 7; const f32x4 q0 = *(const LAS f32x4*)(red1 + tk * 64 + cg * 8), q1 = *(const LAS f32x4*)(red1 + tk * 64 + cg * 8 + 4);
          const float ss = sum_oct(((q0[0] + q0[1]) + (q0[2] + q0[3])) + ((q1[0] + q1[1]) + (q1[2] + q1[3])));
          LAS float* rnl = (LAS float*)(lds + OFF_RN) + wave * 8; if (cg == 0) rnl[tk] = rsqrtf(ss + 1e-12f);
          if (PASSB && latent) { const f32x4 p0 = *(const LAS f32x4*)(red2 + tk * 64 + cg * 8), p1 = *(const LAS f32x4*)(red2 + tk * 64 + cg * 8 + 4);
              const float cf = sum_oct(((p0[0] + p0[1]) + (p0[2] + p0[3])) + ((p1[0] + p1[1]) + (p1[2] + p1[3])));
              if (cg == 0) ((float*)(ws + WS_COEF))[((size_t)ch.d * TX + rowbase + tmin + tk) * 16 + ch.h] = cf; }
          asm volatile("s_waitcnt lgkmcnt(0)" ::: "memory");
          const f32x4 n0 = *(const LAS f32x4*)rnl, n1 = *(const LAS f32x4*)(rnl + 4);
#pragma unroll
          for (int jj = 0; jj < 8; ++jj) { const float rn = jj < 4 ? n0[jj & 3] : n1[jj & 3]; kkv[jj] *= rn; akv[jj] *= rn; } }
        if (ch.d) { float s = 0.f;
#pragma unroll
            for (int jj = 7; jj >= 0; --jj) { s += lgw[jj]; cum[jj] = s; } ((LAS float*)(lds + OFF_WTOT))[wave * 64 + lane] = s; }
        else { float s = 0.f;
#pragma unroll
            for (int jj = 0; jj < 8; ++jj) { s += lgw[jj]; cum[jj] = s; } ((LAS float*)(lds + OFF_WTOT))[wave * 64 + lane] = s; }
    }
    CS_BAR();
    {
        const LAS float* wt = (const LAS float*)(lds + OFF_WTOT);
        float pre = 0.f, tot = 0.f;
#pragma unroll
        for (int w = 0; w < 8; ++w) { const float v = wt[w * 64 + lane]; tot += v; pre += (w < wave) ? v : 0.f; }
        if (wave == 0) ((LAS float*)(lds + OFF_GC))[lane] = __expf(tot);
        float kkdT[8], nakT[8], kbT[8], vT[8];
#pragma unroll
        for (int jj = 0; jj < 8; ++jj) {
            const int i = ch.d ? 7 - jj : jj, t = wave * 8 + i;
            const float cm = pre + cum[jj], e1 = __expf(cm - lgw[jj]), e2 = __expf(cm), e3 = __expf(-cm), e4 = __expf(tot - cm);
            const float kkd = kkv[jj] * e1;
            *(LAS bf16_t*)(CS_AR(S_KKD) + t * RS + lane * 2) = (bf16_t)cvt_pk_bf16(kkd, 0.f);
            *(LAS bf16_t*)(CS_AR(S_RD) + t * RS + lane * 2) = (bf16_t)cvt_pk_bf16(rr[jj] * e2, 0.f);
            *(LAS bf16_t*)(CS_AR(S_KINV) + t * RS + lane * 2) = (bf16_t)cvt_pk_bf16(kmv[jj] * e3, 0.f);
            *(LAS bf16_t*)(CS_AR(S_AKINV) + t * RS + lane * 2) = (bf16_t)cvt_pk_bf16(akv[jj] * e3, 0.f);
            if (ch.d) { kkdT[7 - jj] = kkd; nakT[7 - jj] = -akv[jj] * e4; kbT[7 - jj] = kmv[jj] * e4; vT[7 - jj] = vv[jj]; }
            else { kkdT[jj] = kkd; nakT[jj] = -akv[jj] * e4; kbT[jj] = kmv[jj] * e4; vT[jj] = vv[jj]; }
        }
        *(LAS u32x4*)(CS_AR(S_KKDT) + lane * RS + wave * 16) = pack8c(kkdT); *(LAS u32x4*)(CS_AR(S_NAKBT) + lane * RS + wave * 16) = pack8c(nakT);
        *(LAS u32x4*)(CS_AR(S_KBART) + lane * RS + wave * 16) = pack8c(kbT); *(LAS u32x4*)(CS_AR(S_VT) + lane * RS + wave * 16) = pack8c(vT);
    }
    if (c + 1 < c_end) pf_issue(pf, ws, ch, c + 1, wave, lane);
    CS_BAR();
    {
        constexpr int NTASK = PASSB ? 15 : 9;
        int pA, kA, pB, kB; { const int t0 = 2 * wave, t1 = 2 * wave + 1; pA = t0 / 3; kA = t0 % 3; pB = t1 / 3; kB = t1 % 3; if (!PASSB) { if (pA >= 1) pA += 2; if (pB >= 1) pB += 2; } }
        const bool doA = 2 * wave < NTASK, doB = 2 * wave + 1 < NTASK;
#define S1_GEOM(p, k, m0, n0, sx, sy, so) const bool lw_##m0 = ((p) == 0 || (p) == 4); const int m0 = (k) == 0 ? 0 : ((k) == 1 ? 32 : (lw_##m0 ? 32 : 0)), n0 = (k) == 0 ? 0 : ((k) == 1 ? 32 : (lw_##m0 ? 0 : 32)); \
        const int sx = ((p) == 0 || (p) == 4) ? S_KKD : ((p) == 1 ? S_KINV : S_AKINV), sy = (p) == 0 ? S_KINV : ((p) == 4 ? S_AKINV : ((p) == 3 ? S_KKD : S_RD)), so = (p) == 0 ? S_AAKT : ((p) == 1 ? S_AQK : ((p) == 2 ? S_NAQA : ((p) == 3 ? S_N : S_NT)));
#define S1_FIN(p, acc, m0, n0, so) do { if ((p) == 0) mask_tile<0, false>(acc, m0, n0, r32, hi); else if ((p) == 1) mask_tile<1, false>(acc, m0, n0, r32, hi); else if ((p) == 2) mask_tile<1, true>(acc, m0, n0, r32, hi); \
            else if ((p) == 3) mask_tile<2, true>(acc, m0, n0, r32, hi); else mask_tile<0, true>(acc, m0, n0, r32, hi); \
            store_nat(CS_AR(so), m0, n0, acc, r32, hi); if ((p) == 4) store_nat(CS_AR(S_F2), m0, n0, acc, r32, hi); } while (0)
        if (doA) {
            S1_GEOM(pA, kA, mA, nA, sxA, syA, soA) S1_GEOM(pB, kB, mB, nB, sxB, syB, soB)
            f32x16 a0 = {}, a1 = {};
            if (doB) { tile2_nt(a0, CS_AR(sxA), mA, CS_AR(syA), nA, a1, CS_AR(sxB), mB, CS_AR(syB), nB, r32, hi); S1_FIN(pA, a0, mA, nA, soA); S1_FIN(pB, a1, mB, nB, soB); }
            else { a0 = tile_nt<0, 4>(a0, CS_AR(sxA), mA, CS_AR(syA), nA, r32, hi); S1_FIN(pA, a0, mA, nA, soA); }
        }
        if (wave == 7) {
            store_zero(CS_AR(S_AAKT), 0, 32, r32, hi); store_zero(CS_AR(S_N), 32, 0, r32, hi); store_zero(CS_AR(S_NT), 0, 32, r32, hi); store_zero(CS_AR(S_F2), 0, 32, r32, hi);
            if (PASSB) { store_zero(CS_AR(S_AQK), 32, 0, r32, hi); store_zero(CS_AR(S_NAQA), 32, 0, r32, hi); } }
#undef S1_GEOM
#undef S1_FIN
    }
    CS_BAR();
    if (wave < 2) {
        const int r0 = 32 * wave, k0 = 2 * wave;
#define T32(acc, X, xr, xk, Y, yr, yk) do { _Pragma("unroll") for (int ks = 0; ks < 2; ++ks) acc = __builtin_amdgcn_mfma_f32_32x32x16_bf16( \
            *(const LAS bf16x8*)(CS_AR(X) + ((xr) + r32) * RS + ((xk) + ks) * 32 + hi * 16), *(const LAS bf16x8*)(CS_AR(Y) + ((yr) + r32) * RS + ((yk) + ks) * 32 + hi * 16), acc, 0, 0, 0); } while (0)
#define ADD_I(acc) do { _Pragma("unroll") for (int r = 0; r < 16; ++r) if ((r & 3) + 8 * (r >> 2) + 4 * hi == r32) acc[r] += 1.0f; } while (0)
#define WWAIT() asm volatile("s_waitcnt lgkmcnt(0)" ::: "memory")
#define INV_IT(XN, XNT, ON, ONT, DOSQ, PN, PNT, FI, FO, EI, EIr, EIk, EO, DOF, LASTI) do { \
            f32x16 d1 = {}, d2 = {}, df = {}, de = {}; \
            if (DOSQ) { T32(d1, XN, r0, k0, XNT, r0, k0); T32(d2, XNT, r0, k0, XN, r0, k0); } \
            if (DOF) { T32(df, PN, r0, k0, FI, r0, k0); add_nat(df, CS_AR(FI), r0, r0, r32, hi); add_nat(df, CS_AR(PNT), r0, r0, r32, hi); if (LASTI) ADD_I(df); \
                if (wave == 1) { T32(de, PNT, r0, k0, EI, EIr, EIk); add_nat(de, CS_AR(EI), 16 * (EIk), EIr, r32, hi); add_nat(de, CS_AR(PN), r0, r0, r32, hi); if (LASTI) ADD_I(de); } } \
            if (DOSQ) { store_nat(CS_AR(ONT), r0, r0, d1, r32, hi); store_nat(CS_AR(ON), r0, r0, d2, r32, hi); } \
            if (DOF) { store_nat(CS_AR(FO), r0, r0, df, r32, hi); if (wave == 1) store_nat(CS_AR(EO), 0, 32, de, r32, hi); } \
            WWAIT(); } while (0)
        INV_IT(S_N, S_NT, S_NB, S_NBT, true, 0, 0, 0, 0, 0, 0, 0, 0, false, false);
        INV_IT(S_NB, S_NBT, S_N, S_NT, true, S_NB, S_NBT, S_F2, S_F1, S_N, 32, 2, S_NB, true, false);
        INV_IT(S_N, S_NT, S_NB, S_NBT, true, S_N, S_NT, S_F1, S_F2, S_NB, 32, 0, S_NBT, true, false);
        INV_IT(S_NB, S_NBT, S_N, S_NT, true, S_NB, S_NBT, S_F2, S_F1, S_NBT, 32, 0, S_NB, true, false);
        INV_IT(0, 0, 0, 0, false, S_N, S_NT, S_F1, S_F2, S_NB, 32, 0, S_NBT, true, true);
    }
    CS_BAR();
    if (wave == 1) {
        f32x16 z = {}; T32(z, S_N, 32, 0, S_F2, 0, 0); store_nat(CS_AR(S_F1), 32, 0, z, r32, hi); WWAIT();
        f32x16 t = {}; T32(t, S_NBT, 32, 0, S_F1, 0, 2); store_nat(CS_AR(S_F2), 32, 0, t, r32, hi);
    }
    CS_BAR();
#undef T32
#undef ADD_I
#undef WWAIT
#undef INV_IT
    { const int p = wave >> 2, m0 = ((wave >> 1) & 1) * 32, n0 = (wave & 1) * 32; f32x16 acc = {};
      if (p == 0) { acc = tile_nt<0, 4>(acc, CS_AR(S_F2), m0, CS_AR(S_NAKBT), n0, r32, hi); store_nat(CS_AR(S_G1), m0, n0, acc, r32, hi); }
      else if (PASSB) { if (m0 == 32 && n0 == 0) store_zero(CS_AR(S_G2), m0, n0, r32, hi);
          else { acc = tile_nt<0, 4>(acc, CS_AR(S_F2), m0, CS_AR(S_NAQA), n0, r32, hi); store_nat(CS_AR(S_G2), m0, n0, acc, r32, hi); } } }
    CS_BAR();
    bf16_t* rec = (bf16_t*)(ws + WS_SCAN) + ((size_t)((ch.d * 2 + ch.b) * 16 + ch.h) * NCHUNK + c) * (4 * 4096);
    { const int q = wave >> 2, m0 = ((wave >> 1) & 1) * 32, n0 = (wave & 1) * 32;
      if (q == 0) {
          f32x16 a0 = {}, a1 = {}; tile2_nt(a0, CS_AR(S_KKDT), m0, CS_AR(S_G1), n0, a1, CS_AR(S_AAKT), m0, CS_AR(S_G1), n0, r32, hi);
          if (m0 == n0) { const float gc = ((const LAS float*)(lds + OFF_GC))[n0 + r32];
#pragma unroll
              for (int r = 0; r < 16; ++r) if ((r & 3) + 8 * (r >> 2) + 4 * hi == r32) a0[r] += gc; }
          store_nat_g(rec, m0, n0, a0, r32, hi); store_nat(CS_AR(S_M2), m0, n0, a1, r32, hi);
      } else if (PASSB) {
          f32x16 a0 = {}, a1 = {}; tile2_nt(a0, CS_AR(S_KKDT), m0, CS_AR(S_G2), n0, a1, CS_AR(S_AAKT), m0, CS_AR(S_G2), n0, r32, hi);
          add_nat(a0, CS_AR(S_RD), m0, n0, r32, hi); store_nat_g(rec + 4096, m0, n0, a0, r32, hi); store_nat(CS_AR(S_M4), m0, n0, a1, r32, hi);
      } }
    CS_BAR();
    { const int p = wave >> 2, m0 = ((wave >> 1) & 1) * 32, n0 = (wave & 1) * 32; f32x16 a0 = {}, a1 = {};
      if (p == 0) {
          tile2_nt(a0, CS_AR(S_KBART), m0, CS_AR(S_VT), n0, a1, CS_AR(S_M2), m0, CS_AR(S_VT), n0, r32, hi); a0 = a0 + a1;
          store_nat_g(rec + 8192, m0, n0, a0, r32, hi);
      } else if (latent) {
          tile2_nt(a0, CS_AR(S_AQK), m0, CS_AR(S_VT), n0, a1, CS_AR(S_M4), m0, CS_AR(S_VT), n0, r32, hi); a0 = a0 + a1;
          store_nat_g(rec + 12288, m0, n0, a0, r32, hi);
      } }
    CS_BAR();
}

__device__ __forceinline__ void scan_stage1(LAS unsigned char* lds, unsigned char* ws, int unit, int tid, int wave, int lane) {
    const int chain = (unit & 7) * 8 + ((unit >> 3) >> 2), seg = (unit >> 3) & 3;
    const Chain ch{chain >> 5, (chain >> 4) & 1, chain & 15};
    const int r32 = lane & 31, hi = lane >> 5;
    ChainConst cc;
    { const int chn = ch.h * 64 + lane; const float* cwp = kin(8);
#pragma unroll
      for (int t = 0; t < 3; ++t)
#pragma unroll
          for (int e = 0; e < 3; ++e) cc.cw[t][e] = cwp[t * 3072 + e * 1024 + chn];
      cc.w0c = kin(9)[ch.d * 1024 + chn]; cc.a0c = kin(11)[ch.d * 1024 + chn]; cc.kkc = kin(13)[chn]; cc.kac = kin(14)[chn]; cc.rkc = kin(15)[chn];
      const int type = wave >> 2, ni = wave & 1, g = type * 2 + ch.d;
      const bf16_t* yp = (const bf16_t*)(ws + WS_WLORA) + (size_t)(g * 1024 + ch.h * 64 + 32 * ni + r32) * 256 + g * 64 + hi * 8;
#pragma unroll
      for (int ks = 0; ks < 4; ++ks) cc.wl[ks] = *(const bf16x8*)(yp + ks * 16); }
    Prefetch pf; pf_issue(pf, ws, ch, seg * CPS, wave, lane);
    for (int c = seg * CPS; c < (seg + 1) * CPS; ++c) chunk(lds, ws, ch, cc, pf, c, (seg + 1) * CPS, tid, wave, lane);
}

__device__ __forceinline__ void scan_stage2(LAS unsigned char* lds, unsigned char* ws, int chain, int iq, int tid, int wave, int lane) {
    unsigned char* recs = ws + WS_SCAN + (size_t)chain * NCHUNK * REC_BYTES;
    constexpr int RSLOT = 20480, NRING = 5, AHEAD = 4, OFF_HB = NRING * RSLOT;
    const int r32 = lane & 31, hi = lane >> 5, qr = 16 * iq + (r32 & 15), sw = (qr >> 1) & 7;
#define FRAG(M, rowb, s) ({ const int row_ = (rowb) + r32, k_ = (row_ >> 1) & 7; const u32x2 lo_ = *(const LAS u32x2*)((M) + row_ * 128 + (((2 * (s)) ^ k_) << 4) + 8 * hi); \
            const u32x2 hi_ = *(const LAS u32x2*)((M) + row_ * 128 + (((2 * (s) + 1) ^ k_) << 4) + 8 * hi); const u32x4 w_ = {lo_.x, lo_.y, hi_.x, hi_.y}; __builtin_bit_cast(bf16x8, w_); })
    if (wave >= 2) {
        if (wave < 7) {
        const int lw = wave - 2;
        unsigned soff[4];
#pragma unroll
        for (int k = 0; k < 4; ++k) { const int i = lw * 4 + k;
            const int mat = i < 16 ? (i >> 3) : (i < 18 ? 2 : 3), prow = (i < 16 ? (i & 7) : (i & 1)) * 8 + (lane >> 3), row = prow + (i < 16 ? 0 : 16 * iq), cp = lane & 7;
            soff[k] = (unsigned)(mat * 8192 + row * 128 + ((cp ^ ((row >> 1) & 7)) << 4)); }
#define DMA_CHUNK(c_) do { const unsigned char* rp_ = recs + (size_t)(c_) * REC_BYTES; LAS unsigned char* dp_ = lds + ((c_) % NRING) * RSLOT + lw * 4096; \
            _Pragma("unroll") for (int k = 0; k < 4; ++k) __builtin_amdgcn_global_load_lds((const unsigned*)(rp_ + soff[k]), (LAS unsigned*)(dp_ + k * 1024), 16, 0, 0); } while (0)
        DMA_CHUNK(0); DMA_CHUNK(1); DMA_CHUNK(2); DMA_CHUNK(3);
        asm volatile("s_waitcnt vmcnt(12)\n\ts_barrier" ::: "memory");
        for (int c = 0; c < NCHUNK; ++c) {
            if (c + AHEAD < NCHUNK) { DMA_CHUNK(c + AHEAD); asm volatile("s_waitcnt vmcnt(12)\n\ts_barrier" ::: "memory"); }
            else asm volatile("s_waitcnt vmcnt(0)\n\ts_barrier" ::: "memory");
        }
#undef DMA_CHUNK
        } else { for (int c = 0; c <= NCHUNK; ++c) asm volatile("s_barrier" ::: "memory"); }
    } else if (wave == 0) {
        f32x16 h0 = {}, h1 = {};
        bf16x8 hb[4];
#pragma unroll
        for (int s4 = 0; s4 < 4; ++s4) { const u32x4 z = {0u, 0u, 0u, 0u}; hb[s4] = __builtin_bit_cast(bf16x8, z); *(LAS u32x4*)(lds + OFF_HB + s4 * 1024 + lane * 16) = z; }
        CS_BAR();
        for (int c = 0; c < NCHUNK; ++c) {
            const LAS unsigned char* Pm = lds + (c % NRING) * RSLOT; const LAS unsigned char* Qm = Pm + 16384 - 16 * iq * 128;
            bf16x8 pa[2][4]; u32x2 qv[2][4];
#pragma unroll
            for (int s4 = 0; s4 < 4; ++s4) { pa[0][s4] = FRAG(Pm, 0, s4); pa[1][s4] = FRAG(Pm, 32, s4); }
#pragma unroll
            for (int g = 0; g < 4; ++g) { qv[0][g] = *(const LAS u32x2*)(Qm + qr * 128 + ((g ^ sw) << 4) + 8 * hi); qv[1][g] = *(const LAS u32x2*)(Qm + qr * 128 + (((4 + g) ^ sw) << 4) + 8 * hi); }
            asm volatile("s_waitcnt lgkmcnt(0)" ::: "memory"); __builtin_amdgcn_sched_barrier(0);
            f32x16 n0, n1;
#pragma unroll
            for (int g = 0; g < 4; ++g) { n0[4 * g] = bflo(qv[0][g].x); n0[4 * g + 1] = bfhi(qv[0][g].x); n0[4 * g + 2] = bflo(qv[0][g].y); n0[4 * g + 3] = bfhi(qv[0][g].y);
                n1[4 * g] = bflo(qv[1][g].x); n1[4 * g + 1] = bfhi(qv[1][g].x); n1[4 * g + 2] = bflo(qv[1][g].y); n1[4 * g + 3] = bfhi(qv[1][g].y); }
#pragma unroll
            for (int s4 = 0; s4 < 4; ++s4) { n0 = __builtin_amdgcn_mfma_f32_32x32x16_bf16(pa[0][s4], hb[s4], n0, 0, 0, 0); n1 = __builtin_amdgcn_mfma_f32_32x32x16_bf16(pa[1][s4], hb[s4], n1, 0, 0, 0); }
            h0 = n0; h1 = n1;
            LAS unsigned char* hbw = lds + OFF_HB + ((c + 1) & 1) * 4096 + lane * 16;
#pragma unroll
            for (int s4 = 0; s4 < 4; ++s4) { const f32x16& hs = (s4 < 2) ? h0 : h1; const int o = 8 * (s4 & 1);
                u32x4 w; w.x = cvt_pk_bf16(hs[o], hs[o + 1]); w.y = cvt_pk_bf16(hs[o + 2], hs[o + 3]); w.z = cvt_pk_bf16(hs[o + 4], hs[o + 5]); w.w = cvt_pk_bf16(hs[o + 6], hs[o + 7]);
                hb[s4] = __builtin_bit_cast(bf16x8, w); *(LAS u32x4*)(hbw + s4 * 1024) = w; }
            CS_BAR();
        }
    } else {
        CS_BAR();
        for (int c = 0; c < NCHUNK; ++c) {
            const LAS unsigned char* Pm = lds + (c % NRING) * RSLOT; const LAS unsigned char* Rm = Pm + 8192; const LAS unsigned char* Ym = Pm + 18432 - 16 * iq * 128;
            if (c >= CTXL / 64) {
                bf16x8 ra[2][4], hb[4]; u32x2 yv[2][4];
                const LAS unsigned char* hbr = lds + OFF_HB + (c & 1) * 4096 + lane * 16;
#pragma unroll
                for (int s4 = 0; s4 < 4; ++s4) { ra[0][s4] = FRAG(Rm, 0, s4); ra[1][s4] = FRAG(Rm, 32, s4); hb[s4] = *(const LAS bf16x8*)(hbr + s4 * 1024); }
#pragma unroll
                for (int g = 0; g < 4; ++g) { yv[0][g] = *(const LAS u32x2*)(Ym + qr * 128 + ((g ^ sw) << 4) + 8 * hi); yv[1][g] = *(const LAS u32x2*)(Ym + qr * 128 + (((4 + g) ^ sw) << 4) + 8 * hi); }
                asm volatile("s_waitcnt lgkmcnt(0)" ::: "memory"); __builtin_amdgcn_sched_barrier(0);
                f32x16 y0, y1;
#pragma unroll
                for (int g = 0; g < 4; ++g) { y0[4 * g] = bflo(yv[0][g].x); y0[4 * g + 1] = bfhi(yv[0][g].x); y0[4 * g + 2] = bflo(yv[0][g].y); y0[4 * g + 3] = bfhi(yv[0][g].y);
                    y1[4 * g] = bflo(yv[1][g].x); y1[4 * g + 1] = bfhi(yv[1][g].x); y1[4 * g + 2] = bflo(yv[1][g].y); y1[4 * g + 3] = bfhi(yv[1][g].y); }
#pragma unroll
                for (int s4 = 0; s4 < 4; ++s4) { y0 = __builtin_amdgcn_mfma_f32_32x32x16_bf16(ra[0][s4], hb[s4], y0, 0, 0, 0); y1 = __builtin_amdgcn_mfma_f32_32x32x16_bf16(ra[1][s4], hb[s4], y1, 0, 0, 0); }
                unsigned char* yo = recs + (size_t)c * REC_BYTES + 24576 + qr * 128 + 8 * hi;
#pragma unroll
                for (int g = 0; g < 4; ++g) { u32x2 w0, w1; w0.x = cvt_pk_bf16(y0[4 * g], y0[4 * g + 1]); w0.y = cvt_pk_bf16(y0[4 * g + 2], y0[4 * g + 3]); w1.x = cvt_pk_bf16(y1[4 * g], y1[4 * g + 1]); w1.y = cvt_pk_bf16(y1[4 * g + 2], y1[4 * g + 3]);
                    if (r32 < 16) { *(u32x2*)(yo + 16 * g) = w0; *(u32x2*)(yo + 64 + 16 * g) = w1; } }
            }
            CS_BAR();
        }
    }
#undef FRAG
}
#undef CS_BAR
#undef CS_AR
}

__device__ __forceinline__ void p5_finish(LAS unsigned char* lds, unsigned char* ws, int vb, int G) {
    const int tid = threadIdx.x, tk = tid >> 3, cg = tid & 7;
    const bf16_t* Urkv = (const bf16_t*)(ws + WS_URKV); bf16_t* Z = (bf16_t*)(ws + WS_UZ);
    const float* cff = (const float*)(ws + WS_COEF); const float* cfb = cff + (size_t)TX * 16;
    const float* cwp = kin(8); const float* lnw = kin(16); const float* lnb = kin(17);
    constexpr int NU = NB * RH * (SEQ / 64);
    struct In { u32x4 yf, yb, x0, x1, x2, zw; float cf; };
#define P5_LOAD(I, u_) do { const int cf_ = (u_) & 127, h_ = ((u_) >> 7) & 15, b_ = (u_) >> 11; \
        const unsigned char* rf_ = ws + WS_SCAN + ((size_t)((0 * 2 + b_) * 16 + h_) * cs::NCHUNK + 4 + cf_) * REC_BYTES + 24576; \
        const unsigned char* rb_ = ws + WS_SCAN + ((size_t)((1 * 2 + b_) * 16 + h_) * cs::NCHUNK + 4 + (127 - cf_)) * REC_BYTES + 24576; \
        I.yf = *(const u32x4*)(rf_ + tid * 16); I.yb = *(const u32x4*)(rb_ + tid * 16); \
        const int m_ = b_ * SEQ + cf_ * 64 + tk, tl_ = cf_ * 64 + tk; const bf16_t* p_ = Urkv + (size_t)m_ * LD_RKV + 2048 + h_ * 64 + cg * 8; \
        I.x0 = *(const u32x4*)(p_ - (tl_ > 0 ? LD_RKV : 0)); I.x1 = *(const u32x4*)p_; I.x2 = *(const u32x4*)(p_ + (tl_ < SEQ - 1 ? LD_RKV : 0)); \
        I.zw = *(const u32x4*)(Z + (size_t)m_ * LD_Z + h_ * 64 + cg * 8); I.cf = cff[(size_t)m_ * 16 + h_] + cfb[(size_t)m_ * 16 + h_]; } while (0)
    In cur, nxt;
    for (int ub = vb; ub < NU / 16; ub += G) {
    const int u0 = ub * 16, u1 = u0 + 16;
    float pc0[8], pc1[8], pc2[8], plw[8], plb[8];
    if (u0 < NU) { const int chn0 = ((u0 >> 7) & 15) * 64 + cg * 8;
#pragma unroll
        for (int e = 0; e < 8; ++e) { pc0[e] = cwp[2048 + chn0 + e]; pc1[e] = cwp[3072 + 2048 + chn0 + e]; pc2[e] = cwp[2 * 3072 + 2048 + chn0 + e]; plw[e] = lnw[chn0 + e]; plb[e] = lnb[chn0 + e]; }
        P5_LOAD(cur, u0); }
    for (int u = u0; u < u1; ++u) {
        const int cf = u & 127, h = (u >> 7) & 15, b = u >> 11;
        __syncthreads();
        *(LAS u32x4*)(lds + (tid >> 3) * 144 + (tid & 7) * 16) = cur.yf;
        *(LAS u32x4*)(lds + 9216 + (tid >> 3) * 144 + (tid & 7) * 16) = cur.yb;
        const int m = b * SEQ + cf * 64 + tk, tl = cf * 64 + tk, ch0 = h * 64 + cg * 8;
        float xa[8], xb[8], xc[8], z[8], y[8];
        unpack8(cur.x0, xa); unpack8(cur.x1, xb); unpack8(cur.x2, xc); unpack8(cur.zw, z);
        const float cf_ = cur.cf; const float wl = tl > 0 ? 1.f : 0.f, wr = tl < SEQ - 1 ? 1.f : 0.f;
        if (u + 1 < u1) P5_LOAD(nxt, u + 1);
        __syncthreads();
        float sy = 0.f;
#pragma unroll
        for (int e = 0; e < 8; ++e) { const int i = cg * 8 + e; y[e] = bf2f(*(const LAS bf16_t*)(lds + i * 144 + tk * 2)) + bf2f(*(const LAS bf16_t*)(lds + 9216 + i * 144 + (63 - tk) * 2)); sy += y[e]; }
        const float mu = cs::sum_oct(sy) * (1.f / 64.f);
        float sv = 0.f;
#pragma unroll
        for (int e = 0; e < 8; ++e) { y[e] -= mu; sv += y[e] * y[e]; }
        const float rstd = rsqrtf(cs::sum_oct(sv) * (1.f / 64.f) + GN_EPS);
        float o[8];
#pragma unroll
        for (int e = 0; e < 8; ++e) { const float v = pc0[e] * (wl * xa[e]) + pc1[e] * xb[e] + pc2[e] * (wr * xc[e]);
            o[e] = (y[e] * rstd * plw[e] + plb[e] + cf_ * v) * siluf_(z[e]); }
        *(u32x4*)(Z + (size_t)m * LD_Z + ch0) = pack8c(o);
        cur = nxt;
    }
    }
#undef P5_LOAD
}

__device__ __forceinline__ void p7_mla(const Args& a, int gw, int NGW, int lane) {
    const bf16_t* Usm = (const bf16_t*)(a.ws + WS_USM); bf16_t* Q = (bf16_t*)(a.ws + WS_QRAW); bf16_t* KV = (bf16_t*)(a.ws + WS_KV); bf16_t* KR = (bf16_t*)(a.ws + WS_KR);
    const float* qg = kin(22); const float* kg = kin(23);
    const int h = lane >> 3, j = lane & 7;
    float inv[8];
#pragma unroll
    for (int e = 0; e < 8; ++e) inv[e] = exp2f(-(float)(8 * (j & 1) + e) * 0.8304820237218406f);
    for (int m = gw; m < TT; m += NGW) {
        const bool latent = m < TX; const int tl = m % SEQ;
        const float pos = (float)((j < 4) ? (tl >> 6) : (tl & 63));
        float cs[8], sn[8];
#pragma unroll
        for (int e = 0; e < 8; ++e) { const float ang = pos * inv[e]; float t = ang * 0.15915494309189535f; t -= floorf(t); sn[e] = __builtin_amdgcn_sinf(t); cs[e] = __builtin_amdgcn_cosf(t); }
        float f[8];
        unpack8(*(const u32x4*)(Usm + (size_t)m * LD_SM + 8 * lane), f); const float s_q = rsqrtf(wave_sum(sum8sq(f)) * (1.f / QL) + EPS);
        { const u32x2 w = *(const u32x2*)(Usm + (size_t)m * LD_SM + 512 + 4 * lane); const float t0 = bflo(w.x), t1 = bfhi(w.x), t2 = bflo(w.y), t3 = bfhi(w.y); f[0] = (t0 * t0 + t1 * t1) + (t2 * t2 + t3 * t3); }
        const float s_kv = rsqrtf(wave_sum(f[0]) * (1.f / KVL) + EPS);
        float kr[8]; unpack8(*(const u32x4*)(Usm + (size_t)m * LD_SM + 1024 + 8 * j), kr);
        if (latent) {
            bf16_t* qp = Q + (size_t)m * LD_Q + h * QKD + 8 * j;
            float q0[8], q1[8], q2[8];
            unpack8(*(const u32x4*)(qp), q0); unpack8(*(const u32x4*)(qp + 64), q1); unpack8(*(const u32x4*)(qp + 128), q2);
#pragma unroll
            for (int e = 0; e < 8; ++e) { q0[e] *= s_q; q1[e] *= s_q; q2[e] *= s_q; }
            const float rq = rsqrtf(red8(sum8sq(q0) + sum8sq(q1) + sum8sq(q2)) * (1.f / QKD) + EPS);
#pragma unroll
            for (int e = 0; e < 8; ++e) { q0[e] *= rq * qg[8 * j + e]; q1[e] *= rq * qg[64 + 8 * j + e]; q2[e] *= rq * qg[128 + 8 * j + e]; }
#pragma unroll
            for (int e = 0; e < 8; ++e) { const float pr = __shfl_xor(q2[e], 2); q2[e] = (j & 2) ? (q2[e] * cs[e] + pr * sn[e]) : (q2[e] * cs[e] - pr * sn[e]); }
            *(u32x4*)(qp) = pack8(q0); *(u32x4*)(qp + 64) = pack8(q1); *(u32x4*)(qp + 128) = pack8(q2);
        }
        {
            bf16_t* kp = KV + (size_t)m * LD_KV + h * 256 + 8 * j;
            float k0[8], k1[8], v0[8], v1[8];
            unpack8(*(const u32x4*)(kp), k0); unpack8(*(const u32x4*)(kp + 64), k1); unpack8(*(const u32x4*)(kp + 128), v0); unpack8(*(const u32x4*)(kp + 192), v1);
#pragma unroll
            for (int e = 0; e < 8; ++e) { k0[e] *= s_kv; k1[e] *= s_kv; v0[e] *= s_kv; v1[e] *= s_kv; }
            const float rk = rsqrtf(red8(sum8sq(k0) + sum8sq(k1) + sum8sq(kr)) * (1.f / QKD) + EPS);
            float ro[8];
#pragma unroll
            for (int e = 0; e < 8; ++e) { k0[e] *= rk * kg[8 * j + e]; k1[e] *= rk * kg[64 + 8 * j + e]; ro[e] = kr[e] * rk * kg[128 + 8 * j + e]; }
#pragma unroll
            for (int e = 0; e < 8; ++e) { const float pr = __shfl_xor(ro[e], 2); if (latent) ro[e] = (j & 2) ? (ro[e] * cs[e] + pr * sn[e]) : (ro[e] * cs[e] - pr * sn[e]); }
            *(u32x4*)(kp) = pack8(k0); *(u32x4*)(kp + 64) = pack8(k1); *(u32x4*)(kp + 128) = pack8(v0); *(u32x4*)(kp + 192) = pack8(v1);
            *(u32x4*)(KR + (size_t)m * LD_KR + h * 64 + 8 * j) = pack8(ro);
        }
    }
}


#define XB_TMO      128
#define XB_XCNT(j)  (256  + 64 * (j))
#define XB_XSUB(j)  (1280 + 64 * (j))
#define XB_XGEN(j)  (2304 + 64 * (j))
#define XB_TOP      3328
#define XB_TOPGEN   3392
#define XCD_BAR_WORDS 3456
#define XB_SPIN_CAP (1u << 18)
__device__ __forceinline__ unsigned xb_ld(unsigned* p)              { return __hip_atomic_load(p, __ATOMIC_RELAXED, __HIP_MEMORY_SCOPE_AGENT); }
__device__ __forceinline__ unsigned xb_add(unsigned* p, unsigned v) { return __hip_atomic_fetch_add(p, v, __ATOMIC_RELAXED, __HIP_MEMORY_SCOPE_AGENT); }
__device__ __forceinline__ unsigned xb_xcc_id() { return (unsigned)__builtin_amdgcn_s_getreg((3 << 11) | 20) & 0xFu; }
#define XB_SPIN(cond, bar) do { unsigned _sp = 0; while (cond) { __builtin_amdgcn_s_sleep(1); \
    if ((++_sp & 255u) == 0u) { if (xb_ld(&(bar)[XB_TMO])) break; if (_sp > XB_SPIN_CAP) { atomicAdd(&(bar)[XB_TMO], 1u); break; } } } } while (0)
struct XcdBarrier { unsigned* bar; unsigned x; volatile LAS unsigned* st; };
__device__ __forceinline__ XcdBarrier xcd_barrier_post(unsigned* bar, volatile LAS unsigned* st) {
    XcdBarrier b; b.bar = bar; b.x = xb_xcc_id(); b.st = st;
    if (threadIdx.x == 0) (void)xb_add(&bar[XB_XCNT(b.x)], 1u);
    return b;
}
__device__ __forceinline__ void xcd_barrier_complete(unsigned* bar, unsigned x, unsigned& nloc, unsigned& nx) {
    const unsigned G = gridDim.x * gridDim.y * gridDim.z;
    unsigned sum, cnt, mine, sp = 0u;
    for (;;) {
        sum = 0u; cnt = 0u; mine = 0u;
#pragma unroll
        for (unsigned j = 0; j < 16; ++j) { const unsigned c = xb_ld(&bar[XB_XCNT(j)]); sum += c; cnt += (c > 0u) ? 1u : 0u; mine = (j == x) ? c : mine; }
        if (sum == G) break;
        __builtin_amdgcn_s_sleep(1);
        if ((++sp & 255u) == 0u) { if (xb_ld(&bar[XB_TMO])) break; if (sp > XB_SPIN_CAP) { atomicAdd(&bar[XB_TMO], 1u); break; } }
    }
    nloc = mine > 0u ? mine : 1u; nx = cnt > 0u ? cnt : 1u;
}
__device__ __forceinline__ void xcd_barrier(const XcdBarrier& b) {
    asm volatile("s_waitcnt vmcnt(0)" ::: "memory");
    __syncthreads();
    if (threadIdx.x == 0) {
        unsigned* bar = b.bar;
        __builtin_amdgcn_s_waitcnt(0);
        unsigned nloc = b.st[0], nx = b.st[1];
        if (nloc == 0u) { xcd_barrier_complete(bar, b.x, nloc, nx); b.st[0] = nloc; b.st[1] = nx; }
        const unsigned old = xb_add(&bar[XB_XSUB(b.x)], 1u);
        const unsigned gen = old / nloc;
        if (old + 1u == (gen + 1u) * nloc) {
            __builtin_amdgcn_fence(__ATOMIC_RELEASE, "agent");
            asm volatile("s_waitcnt vmcnt(0)" ::: "memory");
            const unsigned og = xb_add(&bar[XB_TOP], 1u);
            const unsigned tg = og / nx;
            if (og + 1u == (tg + 1u) * nx) xb_add(&bar[XB_TOPGEN], 1u);
            else XB_SPIN(xb_ld(&bar[XB_TOPGEN]) == tg, bar);
            __builtin_amdgcn_fence(__ATOMIC_ACQUIRE, "agent");
            xb_add(&bar[XB_XGEN(b.x)], 1u);
            asm volatile("s_waitcnt vmcnt(0)" ::: "memory");
        } else {
            XB_SPIN(xb_ld(&bar[XB_XGEN(b.x)]) == gen, bar);
            __builtin_amdgcn_fence(__ATOMIC_ACQUIRE, "agent");
            asm volatile("s_waitcnt vmcnt(0)" ::: "memory");
        }
    }
    __syncthreads();
}

constexpr int NPH = 11;
__global__ void __launch_bounds__(NTHREADS, 2) mega_fwd(Args args) {
    extern __shared__ __attribute__((aligned(16))) unsigned char lds_raw[];
    LAS unsigned char* lds = (LAS unsigned char*)lds_raw;
    cg::grid_group grid = cg::this_grid();
    const int tid = threadIdx.x, lane = tid & 63, wave = __builtin_amdgcn_readfirstlane(tid >> 6);
    const int G = gridDim.x, bx = blockIdx.x;
    const int vcu = (G % 8 == 0) ? (bx % 8) * (G / 8) + bx / 8 : bx;
    const int gw = vcu * NWAVES + wave, NGW = G * NWAVES;
    unsigned char* ws = args.ws;
    const int lo = args.ph_lo, hi = args.ph_hi;
    { volatile LAS unsigned* z = (volatile LAS unsigned*)(lds + LDS_BYTES - 256); if (tid < 64) z[tid] = 0u; }
    __syncthreads();
    XcdBarrier xbar = xcd_barrier_post((unsigned*)(ws + WS_CTL), (volatile LAS unsigned*)(lds + LDS_BYTES - 256 + 64));
#ifndef PHMASK
#define PHMASK 0x7ff
#endif
#ifndef PROBE_DUP
#define PROBE_DUP 0
#endif
#define DUP(k) for (int rep_ = 0; rep_ < (((PROBE_DUP >> (k)) & 1) ? 2 : 1); ++rep_)
#define IN(k) (((PHMASK >> (k)) & 1) && lo <= (k) && (k) < hi)
#define SEAM(k) do { if (IN(k) && IN((k) + 1)) { if ((k) == 0) grid.sync(); else xcd_barrier(xbar); } } while (0)

    if (IN(0)) DUP(0) p0_mod(args, lds, bx, tid);
    SEAM(0);
    if (IN(1)) DUP(1) { p1_hm(args, lds, gw, NGW, lane); __syncthreads(); p0_weights<false>(args, lds, gw, NGW, wave, lane); }
    SEAM(1);
    if (IN(2)) DUP(2) {
        pg8::Gemm g{(const bf16_t*)(ws + WS_HM), (const bf16_t*)(ws + WS_WIN), TT, NIN, DM, DM, DM}; pg8::StaticOrder S; S.init(TT, NIN, G, bx);
        pg8::EpiInProj E{(bf16_t*)(ws + WS_URKV), (bf16_t*)(ws + WS_UZ), (bf16_t*)(ws + WS_USM), (bf16_t*)args.out};
        pg8::gemm_phase<pg8::EpiInProj>(lds, g, S, E);
    }
    SEAM(2);
    if (IN(3)) DUP(3) { for (int u = bx; u < 256; u += G) cs::scan_stage1(lds, ws, u, tid, wave, lane); }
    SEAM(3);
    if (IN(4)) DUP(4) {
        for (int u = bx; u < 256; u += G) cs::scan_stage2(lds, ws, (u & 7) * 8 + ((u >> 3) >> 2), (u >> 3) & 3, tid, wave, lane); }
    SEAM(4);
    if (IN(5)) DUP(5) { p5_finish(lds, ws, vcu, G); __syncthreads(); p0_weights<true>(args, lds, gw, NGW, wave, lane); }
    SEAM(5);
    if (IN(6)) DUP(6) {
        { pg8::Gemm g{(const bf16_t*)(ws + WS_USM), (const bf16_t*)(ws + WS_WUQ), TX, 1536, 512, LD_SM, 512}; pg8::StaticOrder S; S.init(TX, 1536, G, bx);
          pg8::EpiBf16 E{(bf16_t*)(ws + WS_QRAW), LD_Q}; pg8::gemm_phase<pg8::EpiBf16>(lds, g, S, E); }
        { pg8::Gemm g{(const bf16_t*)(ws + WS_USM) + 512, (const bf16_t*)(ws + WS_WUKV), TT, 2048, 256, LD_SM, 256}; pg8::StaticOrder S; S.init(TT, 2048, G, G - 1 - bx);
          pg8::EpiBf16 E{(bf16_t*)(ws + WS_KV), LD_KV}; pg8::gemm_phase<pg8::EpiBf16>(lds, g, S, E); }
    }
    SEAM(6);
    if (IN(7)) DUP(7) p7_mla(args, gw, NGW, lane);
    SEAM(7);
    if (IN(8)) DUP(8) {
        for (int u = vcu; u < NB * MH * (SEQ / 256); u += G) { const int bh = (u >> 5), qb = u & 31;
            att::attn_unit(bh / MH, bh % MH, qb, (const bf16_t*)(ws + WS_QRAW), (const bf16_t*)(ws + WS_KV), (const bf16_t*)(ws + WS_KR), nullptr, (bf16_t*)(ws + WS_UZ) + 1024, (char*)lds_raw); }
    }
    SEAM(8);
    if (IN(9)) DUP(9) {
        pg8::Gemm g{(const bf16_t*)(ws + WS_UZ), (const bf16_t*)(ws + WS_WBR), TX, DM, 1024, LD_Z, DM}; pg8::ChainOrder S; S.S.init(TX, DM, G, bx); S.KH = 1024;
        pg8::EpiBranchFused E{(const bf16_t*)args.out, (bf16_t*)(ws + WS_MB)}; pg8::gemm_phase<pg8::EpiBranchFused, pg8::ChainOrder>(lds, g, S, E);
    }
    SEAM(9);
    if (IN(10)) DUP(10) {
        pg8::Gemm g{(const bf16_t*)(ws + WS_MB), (const bf16_t*)(ws + WS_WOUT), TX, DM, DM, DM, DM}; pg8::StaticOrder S; S.init(TX, DM, G, bx);
        pg8::EpiOut E{kin(0), (const float*)(ws + WS_MOD), args.out};
        pg8::gemm_phase<pg8::EpiOut>(lds, g, S, E);
    }
#undef IN
#undef SEAM
}

extern "C" void kernel_launch(void* const* d_in, const int* in_sizes, int n_in, void* d_out, int out_size, void* d_ws, size_t ws_size, hipStream_t stream) {
    static int grid = 0;
    if (grid == 0) {
        if (n_in != 27 || out_size != TX * DM || ws_size < WS_END) { fprintf(stderr, "kernel_launch: unexpected shapes (n_in %d out %d ws %zu)\n", n_in, out_size, ws_size); grid = -1; return; }
        int dev = 0, cus = 0, per_cu = 0;
        hipGetDevice(&dev); hipDeviceGetAttribute(&cus, hipDeviceAttributeMultiprocessorCount, dev);
        hipFuncSetAttribute((const void*)mega_fwd, hipFuncAttributeMaxDynamicSharedMemorySize, LDS_BYTES);
        hipOccupancyMaxActiveBlocksPerMultiprocessor(&per_cu, (const void*)mega_fwd, NTHREADS, LDS_BYTES);
        (void)hipGetLastError();
        if (per_cu < 1) { fprintf(stderr, "kernel_launch: occupancy query says %d blocks per CU\n", per_cu); grid = -1; return; }
        grid = cus;
    }
    if (grid < 0) return;
    if (hipMemsetAsync((char*)d_ws + WS_CTL, 0, 16384, stream) != hipSuccess) { fprintf(stderr, "kernel_launch: memset failed\n"); return; }
    Args a{};
    for (int i = 0; i < 27; ++i) a.in[i] = (const float*)d_in[i];
    a.out = (float*)d_out; a.ws = (unsigned char*)d_ws;
#if MK_N_LAUNCHES == 1
    a.ph_lo = 0; a.ph_hi = NPH;
    void* kargs[] = {&a};
    hipError_t e = hipLaunchCooperativeKernel((const void*)mega_fwd, dim3(grid), dim3(NTHREADS), kargs, LDS_BYTES, stream);
    if (e != hipSuccess) fprintf(stderr, "cooperative launch failed: %s (grid %d)\n", hipGetErrorString(e), grid);
#else
    for (int p = 0; p < NPH; ++p) { a.ph_lo = p; a.ph_hi = p + 1; hipLaunchKernelGGL(mega_fwd, dim3(grid), dim3(NTHREADS), LDS_BYTES, stream, a); }
#endif
}
```

```cpp
#include <hip/hip_runtime.h>
#include <hip/hip_cooperative_groups.h>
#include <cstdio>
#include <cstdint>
namespace cg = cooperative_groups;

#ifndef MK_N_LAUNCHES
#define MK_N_LAUNCHES 1
#endif

constexpr int DM = 2048, NB = 2, SEQ = 8192, CTXL = 256;
constexpr int TX = NB * SEQ, TC = NB * CTXL, TT = TX + TC;
constexpr int RW = 1024, RH = 16, RN = 64;
constexpr int MH = 8, QKD = 192, NOPE = 128, ROPE = 64, VH = 128;
constexpr int QL = 512, KVL = 256;
constexpr int NIN = 10496;
constexpr float EPS = 1e-6f, GN_EPS = 64e-5f;
constexpr int LD_RKV = 3072, LD_Z = 2048, LD_SM = 1280, LD_MG = 4096, LD_LW = 4096, LD_Q = 1536, LD_KV = 2048, LD_KR = 512;

typedef unsigned short bf16_t;
typedef short bf16x8 __attribute__((ext_vector_type(8)));
typedef float f32x4 __attribute__((ext_vector_type(4)));
typedef float f32x2 __attribute__((ext_vector_type(2)));
typedef float f32x16 __attribute__((ext_vector_type(16)));
typedef unsigned u32x4 __attribute__((ext_vector_type(4)));
typedef unsigned u32x2 __attribute__((ext_vector_type(2)));
typedef short s16x4 __attribute__((ext_vector_type(4)));
#define LAS __attribute__((address_space(3)))

constexpr size_t MiB = 1u << 20;
constexpr size_t WS_CTL = 0;
constexpr size_t WS_MOD = 1 * MiB;
constexpr size_t WS_WUQ = 2 * MiB;
constexpr size_t WS_WUKV = 494 * MiB;
constexpr size_t WS_WUKV_OLD = WS_WUQ + (size_t)1536 * 512 * 2;
constexpr size_t WS_WLORA = WS_WUKV_OLD + (size_t)2048 * 256 * 2;
constexpr size_t WS_WBR = WS_WLORA + (size_t)4096 * 256 * 2;
constexpr size_t WS_WBM = WS_WBR + (size_t)2048 * 1024 * 2;
constexpr size_t WS_WOUT = WS_WBM + (size_t)2048 * 1024 * 2;
constexpr size_t WS_URKV = 23 * MiB;
constexpr size_t WS_UZ = 122 * MiB;
constexpr size_t WS_USM = 186 * MiB;
constexpr size_t WS_WIN = 228 * MiB;
constexpr size_t WS_HM = 269 * MiB;
constexpr size_t WS_SCAN = 228 * MiB;
constexpr size_t WS_COEF = 492 * MiB;
constexpr size_t WS_QRAW = 228 * MiB;
constexpr size_t WS_KV = 276 * MiB;
constexpr size_t WS_KR = 342 * MiB;
constexpr size_t WS_MB = 228 * MiB;
constexpr size_t WS_END = 512 * MiB;
constexpr int REC_BYTES = 4 * 8192;
static_assert(WS_WOUT + (size_t)2048 * 2048 * 2 <= WS_URKV, "weights fit");
static_assert(WS_URKV + (size_t)TT * LD_RKV * 2 <= WS_UZ && WS_UZ + (size_t)TX * 2048 * 2 <= WS_USM && WS_USM + (size_t)TT * LD_SM * 2 <= WS_WIN, "U map");
static_assert(WS_WIN + (size_t)NIN * DM * 2 <= WS_HM && WS_HM + (size_t)TT * DM * 2 <= WS_END, "P2 map");
static_assert(WS_SCAN + (size_t)64 * 132 * REC_BYTES <= WS_COEF && WS_COEF + (size_t)2 * TX * 16 * 4 <= WS_END, "scan map");
static_assert(WS_QRAW + (size_t)TX * LD_Q * 2 <= WS_KV && WS_KV + (size_t)TT * LD_KV * 2 <= WS_KR && WS_KR + (size_t)TT * LD_KR * 2 <= WS_COEF, "mla map");
static_assert(WS_MB + (size_t)TX * DM * 2 <= WS_END, "merge map");

__device__ __forceinline__ unsigned f2bf(float f) { unsigned u = __builtin_bit_cast(unsigned, f); return (u + 0x7fffu + ((u >> 16) & 1u)) >> 16; }
__device__ __forceinline__ unsigned pk2(float lo, float hi) { return f2bf(lo) | (f2bf(hi) << 16); }
__device__ __forceinline__ float bf2f(unsigned short h) { return __builtin_bit_cast(float, (unsigned)h << 16); }
__device__ __forceinline__ float bflo(unsigned w) { return __builtin_bit_cast(float, w << 16); }
__device__ __forceinline__ float bfhi(unsigned w) { return __builtin_bit_cast(float, w & 0xffff0000u); }
typedef __bf16 bf16x2_t __attribute__((ext_vector_type(2)));
__device__ __forceinline__ unsigned cvt_pk_bf16(float lo, float hi) { const f32x2 v = {lo, hi}; const bf16x2_t b = __builtin_convertvector(v, bf16x2_t); return __builtin_bit_cast(unsigned, b); }
__device__ __forceinline__ float fast_sigmoid(float x) { return __builtin_amdgcn_rcpf(1.0f + __expf(-x)); }
__device__ __forceinline__ float sigmoidf_(float x) { return 1.0f / (1.0f + __expf(-x)); }
__device__ __forceinline__ float siluf_(float x) { return x / (1.0f + __expf(-x)); }
__device__ __forceinline__ float wave_sum(float v) {
#pragma unroll
    for (int o = 1; o < 64; o <<= 1) v += __shfl_xor(v, o);
    return v;
}
#define LDS_WAIT() asm volatile("s_waitcnt lgkmcnt(0)" ::: "memory")
#define VM_WAIT() asm volatile("s_waitcnt vmcnt(0)" ::: "memory")

namespace pg8 {
constexpr int BM = 256, BK = 64, HALF = 128, HTB = HALF * BK * 2  , STAGE_BYTES = 8 * HTB, NXCD = 8, WGM = 8;
__host__ __device__ __forceinline__ int lds_byte(int r, int c) { const int st = (r >> 4) * 2 + (c >> 5), rr = r & 15, cc = c & 31, ob = rr * 64 + cc * 2; return st * 1024 + (ob ^ (((ob >> 9) & 1) << 5)); }
__host__ __device__ __forceinline__ void stage_rc(int b, int& R, int& C) { const int st = b / 1024, sb = b % 1024, swz = sb ^ (((sb >> 9) & 1) << 5); R = (st >> 1) * 16 + swz / 64; C = (st & 1) * 32 + (swz % 64) / 2; }
__host__ __device__ __forceinline__ int perm32(int rho) { const int n = rho >> 4, i = rho & 15; return 8 * (i >> 2) + 4 * n + (i & 3); }

struct Unit { int pm, pn, kofs, kind; };
struct Gemm { const bf16_t* A; const bf16_t* Bt; int M, N, K, lda, ldb; };

struct StaticOrder {
    static constexpr bool HETERO = false;
    int nM, nN, nwg, G, c;
    __host__ __device__ void init(int M, int N, int G_, int c_) { nM = M / BM; nN = N / BM; nwg = nM * nN; G = G_; c = c_; }
    __host__ __device__ bool next(int i, Unit& u) const {
        const long L = (long)i * G + c; if (L >= nwg) return false;
        int wgid = (int)L; { const int q = nwg / NXCD, r = nwg % NXCD, xcd = wgid % NXCD, off = wgid / NXCD; wgid = (xcd < r ? xcd * (q + 1) : r * (q + 1) + (xcd - r) * q) + off; }
        const int nig = WGM * nN, gid = wgid / nig, fm = gid * WGM, gsz = (nM - fm) < WGM ? (nM - fm) : WGM;
        u.pm = fm + ((wgid % nig) % gsz); u.pn = (wgid % nig) / gsz; u.kofs = 0; u.kind = 0; return true;
    }
};
struct DualOrder { static constexpr bool HETERO = true; StaticOrder S0, S1; const bf16_t* A1; const bf16_t* B1; int nt1, n0;
    __host__ __device__ bool next(int i, Unit& u) const { if (i < n0) return S0.next(i, u); if (!S1.next(i - n0, u)) return false; u.kind = 1; return true; } };
struct ChainOrder { static constexpr bool HETERO = false; StaticOrder S; int KH;
    __host__ __device__ bool next(int i, Unit& u) const { if (!S.next(i >> 1, u)) return false; u.kofs = (i & 1) * KH; return true; } };

template <class Epi, class Sched = StaticOrder, bool ALIGN_EPI = true, bool SP2 = true>
__device__ __forceinline__ void gemm_phase(LAS unsigned char* lds, const Gemm g, const Sched& S, const Epi& E) {
    const int tid = threadIdx.x, wid = __builtin_amdgcn_readfirstlane(tid >> 6), lane = tid & 63, wr = wid >> 2, wc = wid & 3, fr = lane & 15, fq = lane >> 4;
    const int K = g.K, nt0 = K / BK;
    unsigned voffA[2], voffB[2];
#pragma unroll
    for (int i = 0; i < 2; ++i) { int R, C; stage_rc(tid * 16 + i * 8192, R, C); const int Rb = Epi::PERM ? ((R & ~31) + perm32(R & 31)) : R;
        voffA[i] = (unsigned)(R * g.lda + C) * 2u; voffB[i] = (unsigned)(Rb * g.ldb + C) * 2u; }
    const size_t kstep = (size_t)(BK * 2);
    const size_t hstepA = (size_t)HALF * g.lda * 2, hstepB = (size_t)HALF * g.ldb * 2;
    const size_t tstepA = 2 * hstepA, tstepB = 2 * hstepB;
    const unsigned ldsw = (unsigned)wid * 1024u;
    const int aoff = lds_byte(wr * 64 + fr, fq * 8), boff = lds_byte(wc * 32 + fr, fq * 8);
#define PG8_SA(b, h) (((b) * 2 + (h)) * HTB)
#define PG8_SB(b, h) ((4 + (b) * 2 + (h)) * HTB)
#define PG8_STAGE(bufoff, gbase, voff) do { _Pragma("unroll") for (int _i = 0; _i < 2; ++_i) \
        __builtin_amdgcn_global_load_lds((const unsigned*)((const char*)(gbase) + (voff)[_i]), (LAS unsigned*)(lds + (bufoff) + ldsw + _i * 8192), 16, 0, 0); } while (0)
#define PG8_LDA(dst, b, h) do { _Pragma("unroll") for (int m = 0; m < 4; ++m) _Pragma("unroll") for (int k = 0; k < 2; ++k) dst[m][k] = *(const LAS bf16x8*)(lds + PG8_SA(b, h) + aoff + m * 2048 + k * 1024); } while (0)
#define PG8_LDB(dst, b, h) do { _Pragma("unroll") for (int n = 0; n < 2; ++n) _Pragma("unroll") for (int k = 0; k < 2; ++k) dst[n][k] = *(const LAS bf16x8*)(lds + PG8_SB(b, h) + boff + n * 2048 + k * 1024); } while (0)
#define PG8_MMA(ai, bj, At, Bt) do { __builtin_amdgcn_s_setprio(1); _Pragma("unroll") for (int m = 0; m < 4; ++m) _Pragma("unroll") for (int n = 0; n < 2; ++n) _Pragma("unroll") for (int k = 0; k < 2; ++k) \
        acc[ai][bj][m][n] = __builtin_amdgcn_mfma_f32_16x16x32_bf16(Bt[n][k], At[m][k], acc[ai][bj][m][n], 0, 0, 0); __builtin_amdgcn_s_setprio(0); } while (0)
#define PG8_WAIT_V(n) asm volatile("s_waitcnt vmcnt(" #n ")" ::: "memory")
#define PG8_WAIT_L(n) asm volatile("s_waitcnt lgkmcnt(" #n ")" ::: "memory")
#define PG8_BAR __builtin_amdgcn_s_barrier()
#define PG8_SCHED __builtin_amdgcn_sched_barrier(0)
    Unit cur, nxt; int ui = 0;
    if (!S.next(0, cur)) return;
    f32x4 acc[2][2][4][2];
#pragma unroll
    for (int a = 0; a < 2; ++a)
#pragma unroll
        for (int b = 0; b < 2; ++b)
#pragma unroll
            for (int m = 0; m < 4; ++m)
#pragma unroll
                for (int n = 0; n < 2; ++n) acc[a][b][m][n] = (f32x4){0.f, 0.f, 0.f, 0.f};
    bf16x8 At[4][2], B0[2][2], B1[2][2];
    auto baseA = [&](const Unit& u) { const char* a_ = (const char*)g.A; if constexpr (Sched::HETERO) { if (u.kind) a_ = (const char*)S.A1; } return a_ + (size_t)u.pm * tstepA + u.kofs * 2; };
    auto baseB = [&](const Unit& u) { const char* b_ = (const char*)g.Bt; if constexpr (Sched::HETERO) { if (u.kind) b_ = (const char*)S.B1; } return b_ + (size_t)u.pn * tstepB + u.kofs * 2; };
    auto nt_of = [&](const Unit& u) { if constexpr (Sched::HETERO) { return u.kind ? S.nt1 : nt0; } else { return nt0; } };
    const char* cA = baseA(cur); const char* cB = baseB(cur); int nt = nt_of(cur);
    if constexpr (SP2) {
        PG8_STAGE(PG8_SB(0, 0), cB, voffB); PG8_STAGE(PG8_SB(0, 1), cB + hstepB, voffB); PG8_STAGE(PG8_SA(0, 0), cA, voffA); PG8_STAGE(PG8_SA(0, 1), cA + hstepA, voffA);
        if (wr == 1) PG8_BAR;
        PG8_WAIT_V(2); PG8_BAR;
        PG8_STAGE(PG8_SB(1, 0), cB + kstep, voffB); PG8_STAGE(PG8_SA(1, 0), cA + kstep, voffA); PG8_STAGE(PG8_SB(1, 1), cB + hstepB + kstep, voffB);
        PG8_WAIT_V(6); PG8_BAR;
    } else {
        PG8_STAGE(PG8_SB(0, 0), cB, voffB); PG8_STAGE(PG8_SA(0, 0), cA, voffA); PG8_STAGE(PG8_SB(0, 1), cB + hstepB, voffB); PG8_STAGE(PG8_SA(0, 1), cA + hstepA, voffA);
        if (wr == 1) PG8_BAR;
        PG8_WAIT_V(4); PG8_BAR;
        PG8_STAGE(PG8_SB(1, 0), cB + kstep, voffB); PG8_STAGE(PG8_SA(1, 0), cA + kstep, voffA); PG8_STAGE(PG8_SB(1, 1), cB + hstepB + kstep, voffB);
        PG8_WAIT_V(6); PG8_BAR;
    }
    for (;;) {
        const bool has_next = S.next(ui + 1, nxt);
        const char* nA = has_next ? baseA(nxt) : cA; const char* nB = has_next ? baseB(nxt) : cB;
        for (int t = 0; t < nt; t += 2) {
            const bool last = (t == nt - 2);
            const char* a1 = cA + (size_t)(t + 1) * kstep;
            const char* a2 = last ? nA : cA + (size_t)(t + 2) * kstep; const char* b2 = last ? nB : cB + (size_t)(t + 2) * kstep;
            const char* a3 = a2 + kstep; const char* b3 = b2 + kstep;
            if constexpr (SP2) {
            PG8_LDB(B0, 0, 0); PG8_LDB(B1, 0, 1); PG8_SCHED; PG8_LDA(At, 0, 0); PG8_STAGE(PG8_SA(1, 1), a1 + hstepA, voffA);
            PG8_WAIT_V(8); PG8_WAIT_L(0); PG8_BAR; PG8_MMA(0, 0, At, B0); PG8_MMA(0, 1, At, B1); PG8_BAR; PG8_SCHED;
            PG8_LDA(At, 0, 1); PG8_STAGE(PG8_SB(0, 0), b2, voffB); PG8_STAGE(PG8_SB(0, 1), b2 + hstepB, voffB); PG8_STAGE(PG8_SA(0, 0), a2, voffA);
            PG8_WAIT_V(8); PG8_WAIT_L(0); PG8_BAR; PG8_MMA(1, 0, At, B0); PG8_MMA(1, 1, At, B1); PG8_BAR; PG8_SCHED;
            PG8_LDB(B0, 1, 0); PG8_LDB(B1, 1, 1); PG8_SCHED; PG8_LDA(At, 1, 0); PG8_STAGE(PG8_SA(0, 1), a2 + hstepA, voffA);
            PG8_WAIT_V(8); PG8_WAIT_L(0); PG8_BAR; PG8_MMA(0, 0, At, B0); PG8_MMA(0, 1, At, B1); PG8_BAR; PG8_SCHED;
            PG8_LDA(At, 1, 1); PG8_STAGE(PG8_SB(1, 0), b3, voffB); PG8_STAGE(PG8_SB(1, 1), b3 + hstepB, voffB); PG8_STAGE(PG8_SA(1, 0), a3, voffA);
            PG8_WAIT_V(8); PG8_WAIT_L(0); PG8_BAR; PG8_MMA(1, 0, At, B0); PG8_MMA(1, 1, At, B1); PG8_BAR; PG8_SCHED;
            } else {
            PG8_LDB(B0, 0, 0); PG8_SCHED; PG8_LDA(At, 0, 0); PG8_STAGE(PG8_SA(1, 1), a1 + hstepA, voffA);
            PG8_WAIT_L(8); PG8_BAR; PG8_WAIT_L(0); PG8_MMA(0, 0, At, B0); PG8_BAR; PG8_SCHED;
            PG8_LDB(B1, 0, 1); PG8_STAGE(PG8_SB(0, 0), b2, voffB);
            PG8_BAR; PG8_WAIT_L(0); PG8_MMA(0, 1, At, B1); PG8_BAR;
            PG8_LDA(At, 0, 1); PG8_STAGE(PG8_SA(0, 0), a2, voffA);
            PG8_BAR; PG8_WAIT_L(0); PG8_MMA(1, 0, At, B0); PG8_BAR; PG8_SCHED;
            PG8_STAGE(PG8_SB(0, 1), b2 + hstepB, voffB);
            PG8_WAIT_V(6); PG8_BAR; PG8_MMA(1, 1, At, B1); PG8_BAR;
            PG8_LDB(B0, 1, 0); PG8_SCHED; PG8_LDA(At, 1, 0); PG8_STAGE(PG8_SA(0, 1), a2 + hstepA, voffA);
            PG8_WAIT_L(8); PG8_BAR; PG8_WAIT_L(0); PG8_MMA(0, 0, At, B0); PG8_BAR; PG8_SCHED;
            PG8_LDB(B1, 1, 1); PG8_STAGE(PG8_SB(1, 0), b3, voffB);
            PG8_BAR; PG8_WAIT_L(0); PG8_MMA(0, 1, At, B1); PG8_BAR;
            PG8_LDA(At, 1, 1); PG8_STAGE(PG8_SA(1, 0), a3, voffA);
            PG8_BAR; PG8_WAIT_L(0); PG8_MMA(1, 0, At, B0); PG8_BAR; PG8_SCHED;
            PG8_STAGE(PG8_SB(1, 1), b3 + hstepB, voffB);
            PG8_WAIT_V(6); PG8_BAR; PG8_MMA(1, 1, At, B1); PG8_BAR;
            }
        }
        if constexpr (ALIGN_EPI) { if (wr == 0) PG8_BAR; }
        bool chained = false;
        if constexpr (Epi::MID) { if (has_next && nxt.pm == cur.pm && nxt.pn == cur.pn) { E.mid(acc, cur, wr, wc, fr, fq); chained = true; } }
        if (!chained) E(acc, cur, wr, wc, fr, fq);
        if (!has_next) break;
        if (!chained) {
#pragma unroll
        for (int a = 0; a < 2; ++a)
#pragma unroll
            for (int b = 0; b < 2; ++b)
#pragma unroll
                for (int m = 0; m < 4; ++m)
#pragma unroll
                    for (int n = 0; n < 2; ++n) acc[a][b][m][n] = (f32x4){0.f, 0.f, 0.f, 0.f};
        }
        cur = nxt; cA = nA; cB = nB; ++ui; nt = nt_of(cur);
        if constexpr (ALIGN_EPI) { if (wr == 1) PG8_BAR; }
    }
    PG8_WAIT_V(0);
    if constexpr (!ALIGN_EPI) { if (wr == 0) PG8_BAR; }
    PG8_BAR;
#undef PG8_SA
#undef PG8_SB
#undef PG8_STAGE
#undef PG8_LDA
#undef PG8_LDB
#undef PG8_MMA
#undef PG8_WAIT_V
#undef PG8_WAIT_L
#undef PG8_BAR
#undef PG8_SCHED
}

struct EpiBf16 {
    static constexpr bool PERM = true; static constexpr bool MID = false;
    bf16_t* O; int ldc;
    __device__ __forceinline__ void operator()(const f32x4 (&acc)[2][2][4][2], const Unit& u, int wr, int wc, int fr, int fq) const {
        const int row0 = u.pm * BM + wr * 64 + fr, col0 = u.pn * BM + wc * 32 + 8 * fq;
#pragma unroll
        for (int ai = 0; ai < 2; ++ai)
#pragma unroll
            for (int m = 0; m < 4; ++m) { bf16_t* rowp = O + (size_t)(row0 + ai * HALF + m * 16) * ldc + col0;
#pragma unroll
                for (int bj = 0; bj < 2; ++bj) { const f32x4 v0 = acc[ai][bj][m][0], v1 = acc[ai][bj][m][1];
                    u32x4 w; w.x = cvt_pk_bf16(v0[0], v0[1]); w.y = cvt_pk_bf16(v0[2], v0[3]); w.z = cvt_pk_bf16(v1[0], v1[1]); w.w = cvt_pk_bf16(v1[2], v1[3]);
                    *(u32x4*)(rowp + bj * HALF) = w; } }
    }
};
struct EpiP6 {
    static constexpr bool PERM = true; static constexpr bool MID = false;
    bf16_t* Oq; bf16_t* Okv;
    __device__ __forceinline__ void operator()(const f32x4 (&acc)[2][2][4][2], const Unit& u, int wr, int wc, int fr, int fq) const {
        bf16_t* O = u.kind ? Okv : Oq; const int ldc = u.kind ? LD_KV : LD_Q;
        const int row0 = u.pm * BM + wr * 64 + fr, col0 = u.pn * BM + wc * 32 + 8 * fq;
#pragma unroll
        for (int ai = 0; ai < 2; ++ai)
#pragma unroll
            for (int m = 0; m < 4; ++m) { bf16_t* rowp = O + (size_t)(row0 + ai * HALF + m * 16) * ldc + col0;
#pragma unroll
                for (int bj = 0; bj < 2; ++bj) { const f32x4 v0 = acc[ai][bj][m][0], v1 = acc[ai][bj][m][1];
                    u32x4 w; w.x = cvt_pk_bf16(v0[0], v0[1]); w.y = cvt_pk_bf16(v0[2], v0[3]); w.z = cvt_pk_bf16(v1[0], v1[1]); w.w = cvt_pk_bf16(v1[2], v1[3]);
                    *(u32x4*)(rowp + bj * HALF) = w; } }
    }
};
struct EpiInProj {
    static constexpr bool PERM = true; static constexpr bool MID = false;
    bf16_t *Urkv, *Uz, *Usm, *Umg;
    __device__ __forceinline__ void operator()(const f32x4 (&acc)[2][2][4][2], const Unit& u, int wr, int wc, int fr, int fq) const {
        bf16_t* base; int ldc, ct; const int pn = u.pn;
        if (pn < 12) { base = Urkv; ldc = LD_RKV; ct = pn; }
        else if (pn < 20) { if (u.pm >= TX / BM) return; base = Uz; ldc = LD_Z; ct = pn - 12; }
        else if (pn < 25) { base = Usm; ldc = LD_SM; ct = pn - 20; }
        else { if (u.pm >= TX / BM) return; base = Umg; ldc = LD_MG; ct = pn - 25; }
        const bool th = (pn == 23);
        const int row0 = u.pm * BM + wr * 64 + fr, col0 = ct * BM + wc * 32 + 8 * fq;
#pragma unroll
        for (int ai = 0; ai < 2; ++ai)
#pragma unroll
            for (int m = 0; m < 4; ++m) { bf16_t* rowp = base + (size_t)(row0 + ai * HALF + m * 16) * ldc + col0;
#pragma unroll
                for (int bj = 0; bj < 2; ++bj) { f32x4 v0 = acc[ai][bj][m][0], v1 = acc[ai][bj][m][1];
                    if (th && bj == 0) {
#pragma unroll
                        for (int e = 0; e < 4; ++e) { v0[e] = tanhf(v0[e]); v1[e] = tanhf(v1[e]); } }
                    u32x4 w; w.x = cvt_pk_bf16(v0[0], v0[1]); w.y = cvt_pk_bf16(v0[2], v0[3]); w.z = cvt_pk_bf16(v1[0], v1[1]); w.w = cvt_pk_bf16(v1[2], v1[3]);
                    *(u32x4*)(rowp + bj * HALF) = w; } }
    }
};
struct EpiBranchFused {
    static constexpr bool PERM = true, MID = true;
    const bf16_t* mg; bf16_t* Mb;
    __device__ __forceinline__ static float ratio(float a, float b) { a = fminf(fmaxf(a, -80.f), 80.f); b = fminf(fmaxf(b, -80.f), 80.f); return (1.0f + __expf(-b)) * __builtin_amdgcn_rcpf(1.0f + __expf(-a)); }
    __device__ __forceinline__ static float sig(float b) { b = fminf(fmaxf(b, -80.f), 80.f); return __builtin_amdgcn_rcpf(1.0f + __expf(-b)); }
    __device__ __forceinline__ void mid(f32x4 (&acc)[2][2][4][2], const Unit& u, int wr, int wc, int fr, int fq) const {
        const bf16_t* gp0 = mg + (size_t)(u.pm * BM + wr * 64 + fr) * LD_MG + u.pn * BM + wc * 32 + 8 * fq;
        u32x4 ga[2][2][2], gb[2][2][2];
#define EBF_LOADM(q) do { _Pragma("unroll") for (int j_ = 0; j_ < 2; ++j_) { const int g_ = 2 * (q) + j_; const bf16_t* gp = gp0 + (size_t)((g_ >> 2) * HALF + (g_ & 3) * 16) * LD_MG; \
            _Pragma("unroll") for (int bj = 0; bj < 2; ++bj) { ga[(q) & 1][j_][bj] = *(const u32x4*)(gp + bj * HALF); gb[(q) & 1][j_][bj] = *(const u32x4*)(gp + DM + bj * HALF); } } } while (0)
        EBF_LOADM(0);
#pragma unroll
        for (int q = 0; q < 4; ++q) {
            if (q + 1 < 4) EBF_LOADM(q + 1);
            __builtin_amdgcn_sched_barrier(0);
#pragma unroll
            for (int j = 0; j < 2; ++j) { const int g = 2 * q + j;
#pragma unroll
                for (int bj = 0; bj < 2; ++bj) { const u32x4 a_ = ga[q & 1][j][bj], b_ = gb[q & 1][j][bj];
                    f32x4& v0 = acc[g >> 2][bj][g & 3][0]; f32x4& v1 = acc[g >> 2][bj][g & 3][1];
                    v0[0] *= ratio(bflo(a_.x), bflo(b_.x)); v0[1] *= ratio(bfhi(a_.x), bfhi(b_.x)); v0[2] *= ratio(bflo(a_.y), bflo(b_.y)); v0[3] *= ratio(bfhi(a_.y), bfhi(b_.y));
                    v1[0] *= ratio(bflo(a_.z), bflo(b_.z)); v1[1] *= ratio(bfhi(a_.z), bfhi(b_.z)); v1[2] *= ratio(bflo(a_.w), bflo(b_.w)); v1[3] *= ratio(bfhi(a_.w), bfhi(b_.w)); } }
            __builtin_amdgcn_sched_barrier(0);
        }
#undef EBF_LOADM
    }
    __device__ __forceinline__ void operator()(const f32x4 (&acc)[2][2][4][2], const Unit& u, int wr, int wc, int fr, int fq) const {
        const size_t row00 = (size_t)(u.pm * BM + wr * 64 + fr); const int col0 = u.pn * BM + wc * 32 + 8 * fq;
        u32x4 gq[2][4][2];
#define EBF_LOADF(q) do { _Pragma("unroll") for (int j_ = 0; j_ < 4; ++j_) { const int g_ = 4 * (q) + j_; const bf16_t* gp = mg + (row00 + (size_t)((g_ >> 2) * HALF + (g_ & 3) * 16)) * LD_MG + DM + col0; \
            _Pragma("unroll") for (int bj = 0; bj < 2; ++bj) gq[(q) & 1][j_][bj] = *(const u32x4*)(gp + bj * HALF); } } while (0)
        EBF_LOADF(0); EBF_LOADF(1);
#pragma unroll
        for (int q = 0; q < 2; ++q) {
            __builtin_amdgcn_sched_barrier(0);
#pragma unroll
            for (int j = 0; j < 4; ++j) { const int g = 4 * q + j; const size_t row = row00 + (size_t)((g >> 2) * HALF + (g & 3) * 16);
#pragma unroll
                for (int bj = 0; bj < 2; ++bj) { const u32x4 b_ = gq[q & 1][j][bj];
                    f32x4 v0 = acc[g >> 2][bj][g & 3][0], v1 = acc[g >> 2][bj][g & 3][1];
                    v0[0] *= sig(bflo(b_.x)); v0[1] *= sig(bfhi(b_.x)); v0[2] *= sig(bflo(b_.y)); v0[3] *= sig(bfhi(b_.y));
                    v1[0] *= sig(bflo(b_.z)); v1[1] *= sig(bfhi(b_.z)); v1[2] *= sig(bflo(b_.w)); v1[3] *= sig(bfhi(b_.w));
                    u32x4 w; w.x = cvt_pk_bf16(v0[0], v0[1]); w.y = cvt_pk_bf16(v0[2], v0[3]); w.z = cvt_pk_bf16(v1[0], v1[1]); w.w = cvt_pk_bf16(v1[2], v1[3]);
                    *(u32x4*)(Mb + row * DM + col0 + bj * HALF) = w; } }
            __builtin_amdgcn_sched_barrier(0);
        }
#undef EBF_LOADF
    }
};
struct EpiOut {
    static constexpr bool PERM = false; static constexpr bool MID = false;
    const float* x; const float* mod; float* out;
    __device__ __forceinline__ void operator()(const f32x4 (&acc)[2][2][4][2], const Unit& u, int wr, int wc, int fr, int fq) const {
        const int b = (u.pm * BM) / SEQ; const float* gate = mod + (size_t)b * 6144 + 4096;
        const int col0 = u.pn * BM + wc * 32 + 4 * fq;
        f32x4 gv[2][2];
#pragma unroll
        for (int bj = 0; bj < 2; ++bj)
#pragma unroll
            for (int n = 0; n < 2; ++n) gv[bj][n] = *(const f32x4*)(gate + col0 + bj * HALF + n * 16);
        const size_t off0 = (size_t)(u.pm * BM + wr * 64 + fr) * DM + col0;
        f32x4 xq[3][2][2];
#define EPO_LOAD(g) do { const size_t off_ = off0 + (size_t)(((g) >> 2) * HALF + ((g) & 3) * 16) * DM; _Pragma("unroll") for (int bj = 0; bj < 2; ++bj) _Pragma("unroll") for (int n = 0; n < 2; ++n) \
            xq[(g) % 3][bj][n] = *(const f32x4*)(x + off_ + bj * HALF + n * 16); } while (0)
        EPO_LOAD(0); EPO_LOAD(1);
#pragma unroll
        for (int g = 0; g < 8; ++g) {
            if (g + 2 < 8) EPO_LOAD(g + 2);
            __builtin_amdgcn_sched_barrier(0);
            const size_t off = off0 + (size_t)((g >> 2) * HALF + (g & 3) * 16) * DM;
#pragma unroll
            for (int bj = 0; bj < 2; ++bj)
#pragma unroll
                for (int n = 0; n < 2; ++n) *(f32x4*)(out + off + bj * HALF + n * 16) = xq[g % 3][bj][n] + gv[bj][n] * acc[g >> 2][bj][g & 3][n];
            __builtin_amdgcn_sched_barrier(0);
        }
#undef EPO_LOAD
    }
};
}

namespace att {
constexpr int NW = 8, QBLK = 32, KVBLK = 64;
constexpr float SCALE = 0.07216878364870322f;
constexpr float THR = 8.f;
constexpr int KROW = 384;
constexpr int SHM_V = KVBLK * VH * 2, SHM_K = KVBLK * KROW;
constexpr int NQREG = 10, SHM_QR = NW * (12 - NQREG) * 1024;
constexpr int SHM_ATTN = 2 * SHM_V + 2 * SHM_K + NW * 64 * 4 + SHM_QR;
#define KSWZ(row, colB) ((row) * att::KROW + ((colB) ^ ((((row) >> 1) & 7) << 4)))
#define SBAR() __builtin_amdgcn_sched_barrier(0)
__device__ __forceinline__ int crow(int r, int hi) { return (r & 3) + 8 * (r >> 2) + 4 * hi; }
__device__ __forceinline__ void partialSM(f32x16& p0, f32x16& p1, float& m_reg, float& mn, float& alpha) {
  constexpr float C = SCALE * 1.4426950408889634f;
  float pmax = p0[0];
#pragma unroll
  for (int r = 1; r < 16; ++r) pmax = fmaxf(pmax, p0[r]);
#pragma unroll
  for (int r = 0; r < 16; ++r) pmax = fmaxf(pmax, p1[r]);
  { auto rr = __builtin_amdgcn_permlane32_swap(__float_as_uint(pmax), __float_as_uint(pmax), false, false);
    pmax = fmaxf(__uint_as_float(rr[0]), __uint_as_float(rr[1])); }
  if (__builtin_expect(__all(pmax - m_reg <= THR / SCALE), 1)) { mn = m_reg; alpha = 1.f; }
  else { mn = fmaxf(m_reg, pmax); alpha = __builtin_amdgcn_exp2f((m_reg - mn) * C); m_reg = mn; }
  float mnC = -mn * C;
#pragma unroll
  for (int r = 0; r < 16; ++r) p0[r] = fmaf(p0[r], C, mnC);
#pragma unroll
  for (int r = 0; r < 16; ++r) p1[r] = fmaf(p1[r], C, mnC);
#pragma unroll
  for (int r = 0; r < 16; ++r) p0[r] = __builtin_amdgcn_exp2f(p0[r]);
}
__device__ __forceinline__ void finishSM(f32x16& p0, f32x16& p1, float alpha, float& l_reg, bf16x8& pa0, bf16x8& pa1, bf16x8& pa2, bf16x8& pa3) {
#pragma unroll
  for (int r = 0; r < 16; ++r) p1[r] = __builtin_amdgcn_exp2f(p1[r]);
  float ps = 0;
#pragma unroll
  for (int r = 0; r < 16; ++r) ps += p0[r];
#pragma unroll
  for (int r = 0; r < 16; ++r) ps += p1[r];
  { auto rr = __builtin_amdgcn_permlane32_swap(__float_as_uint(ps), __float_as_uint(ps), false, false);
    ps = __uint_as_float(rr[0]) + __uint_as_float(rr[1]); }
  l_reg = l_reg * alpha + ps;
#define PK4(P, BASE, OUT) do { unsigned a0 = cvt_pk_bf16(P[BASE + 0], P[BASE + 1]), a1 = cvt_pk_bf16(P[BASE + 2], P[BASE + 3]);   \
    unsigned b0 = cvt_pk_bf16(P[BASE + 4], P[BASE + 5]), b1 = cvt_pk_bf16(P[BASE + 6], P[BASE + 7]);                              \
    auto r0 = __builtin_amdgcn_permlane32_swap(a0, b0, false, false); auto r1 = __builtin_amdgcn_permlane32_swap(a1, b1, false, false); \
    u32x4 w = {r0[0], r1[0], r0[1], r1[1]}; OUT = *reinterpret_cast<bf16x8*>(&w); } while (0)
  PK4(p0, 0, pa0); PK4(p0, 8, pa1); PK4(p1, 0, pa2); PK4(p1, 8, pa3);
#undef PK4
}
__device__ __forceinline__ void qkt(f32x16& p0, f32x16& p1, const char* Ks, const bf16x8* qr, const char* qrl, int r32, int hi) {
  p0 = f32x16{}; p1 = f32x16{};
#pragma unroll
  for (int d0 = 0; d0 < 12; ++d0) { const int cb = (d0 * 16 + hi * 8) * 2;
    bf16x8 b0 = *reinterpret_cast<const bf16x8*>(Ks + KSWZ(r32, cb));
    bf16x8 b1 = *reinterpret_cast<const bf16x8*>(Ks + KSWZ(32 + r32, cb));
    const bf16x8 qf = d0 < NQREG ? qr[d0 < NQREG ? d0 : 0] : *reinterpret_cast<const bf16x8*>(qrl + (d0 - NQREG) * 1024);
    p0 = __builtin_amdgcn_mfma_f32_32x32x16_bf16(b0, qf, p0, 0, 0, 0);
    p1 = __builtin_amdgcn_mfma_f32_32x32x16_bf16(b1, qf, p1, 0, 0, 0); }
}
__device__ __forceinline__ int v_st(int k, int c) { const int kk = (k & ~0xC) | ((k & 4) << 1) | ((k & 8) >> 1); return ((kk >> 3) * 4 + (c >> 5)) * 512 + ((kk & 7) * 32 + (c & 31)) * 2; }
__device__ __forceinline__ int v_rd_base(int lane) { return ((lane & 3) << 3) | (((lane >> 2) & 3) << 6) | (((lane >> 4) & 1) << 5) | (((lane >> 5) & 1) << 8); }
constexpr int v_rd_off(int d0, int ks, int half) { return d0 * 512 + ks * 4096 + half * 2048; }
template <int OFF> __device__ __forceinline__ s16x4 tr_read(int vb) {
  s16x4 r; asm volatile("ds_read_b64_tr_b16 %0, %1 offset:%2" : "=&v"(r) : "v"(vb), "i"(OFF) : "memory"); return r;
}
template <int D0> __device__ __forceinline__ void pv_one(f32x16& od, int vb, bf16x8 pa0, bf16x8 pa1, bf16x8 pa2, bf16x8 pa3) {
  const s16x4 l0 = tr_read<v_rd_off(D0, 0, 0)>(vb), h0 = tr_read<v_rd_off(D0, 0, 1)>(vb), l1 = tr_read<v_rd_off(D0, 1, 0)>(vb), h1 = tr_read<v_rd_off(D0, 1, 1)>(vb);
  const s16x4 l2 = tr_read<v_rd_off(D0, 2, 0)>(vb), h2 = tr_read<v_rd_off(D0, 2, 1)>(vb), l3 = tr_read<v_rd_off(D0, 3, 0)>(vb), h3 = tr_read<v_rd_off(D0, 3, 1)>(vb);
  asm volatile("s_waitcnt lgkmcnt(0)" ::: "memory"); SBAR();
#define PK(L, H) (bf16x8){L[0], L[1], L[2], L[3], H[0], H[1], H[2], H[3]}
  od = __builtin_amdgcn_mfma_f32_32x32x16_bf16(pa0, PK(l0, h0), od, 0, 0, 0);
  od = __builtin_amdgcn_mfma_f32_32x32x16_bf16(pa1, PK(l1, h1), od, 0, 0, 0);
  od = __builtin_amdgcn_mfma_f32_32x32x16_bf16(pa2, PK(l2, h2), od, 0, 0, 0);
  od = __builtin_amdgcn_mfma_f32_32x32x16_bf16(pa3, PK(l3, h3), od, 0, 0, 0);
#undef PK
}
__device__ __forceinline__ void pv_d0(f32x16* o, int vb, bf16x8 pa0, bf16x8 pa1, bf16x8 pa2, bf16x8 pa3) {
  pv_one<0>(o[0], vb, pa0, pa1, pa2, pa3); pv_one<1>(o[1], vb, pa0, pa1, pa2, pa3); pv_one<2>(o[2], vb, pa0, pa1, pa2, pa3); pv_one<3>(o[3], vb, pa0, pa1, pa2, pa3);
}

__device__ __forceinline__ void attn_unit(int b, int h, int qb, const bf16_t* __restrict__ Q, const bf16_t* __restrict__ KV, const bf16_t* __restrict__ KR,
                                          const bf16_t* __restrict__ Uz, bf16_t* __restrict__ Oml, char* lds) {
  const int tid = threadIdx.x, wid = tid >> 6, lane = tid & 63, r32 = lane & 31, hi = lane >> 5;
  char* V_lds = lds; char* K_lds = lds + 2 * SHM_V;
  float* ws = (float*)(lds + 2 * SHM_V + 2 * SHM_K) + wid * 64; float* li_l = ws; float* al_l = ws + 32;
  float m_reg = -1e30f, l_reg = 0; f32x16 o[4] = {}; bf16x8 qr[NQREG];
  char* qrl = lds + 2 * SHM_V + 2 * SHM_K + NW * 64 * 4 + wid * ((12 - NQREG) * 1024) + lane * 16;
  const long qrow0 = (long)b * SEQ + (long)qb * 256;
  const bf16_t* Qw = Q + (qrow0 + wid * QBLK + r32) * LD_Q + h * QKD + hi * 8;
#pragma unroll
  for (int d0 = 0; d0 < NQREG; ++d0) qr[d0] = *reinterpret_cast<const bf16x8*>(Qw + d0 * 16);
#pragma unroll
  for (int d0 = NQREG; d0 < 12; ++d0) *reinterpret_cast<bf16x8*>(qrl + (d0 - NQREG) * 1024) = *reinterpret_cast<const bf16x8*>(Qw + d0 * 16);
  const int sr = tid >> 4, sc = (tid & 15) * 8, vst0 = v_st(sr, sc), vst1 = v_st(32 + sr, sc);
  const int rr_ = tid >> 3, rc_ = (tid & 7) * 8;
  const int vb0 = (int)(uintptr_t)V_lds + v_rd_base(lane);
  const unsigned offk = (unsigned)((sr * LD_KV + h * 256 + sc) * 2), offr = (unsigned)((rr_ * LD_KR + h * 64 + rc_) * 2);
  struct { bf16x8 vs0, vs1, ks0, ks1, kr; } sr_[1];
#define TROW(t) ((t) < 128 ? (long)b * SEQ + (long)(t) * KVBLK : (long)TX + (long)b * CTXL + (long)((t) - 128) * KVBLK)
#define SLOAD(i, t) do { const char* kvt_ = (const char*)KV + (size_t)TROW(t) * (LD_KV * 2); const char* krt_ = (const char*)KR + (size_t)TROW(t) * (LD_KR * 2); \
    sr_[i].vs0 = *reinterpret_cast<const bf16x8*>(kvt_ + offk + 256u); sr_[i].vs1 = *reinterpret_cast<const bf16x8*>(kvt_ + offk + (unsigned)(32 * LD_KV * 2 + 256)); \
    sr_[i].ks0 = *reinterpret_cast<const bf16x8*>(kvt_ + offk); sr_[i].ks1 = *reinterpret_cast<const bf16x8*>(kvt_ + offk + (unsigned)(32 * LD_KV * 2)); \
    sr_[i].kr = *reinterpret_cast<const bf16x8*>(krt_ + offr); } while (0)
#define SWRITE(bb, i) do { *(bf16x8*)(V_lds + (bb) * SHM_V + vst0) = sr_[i].vs0;          \
    *(bf16x8*)(V_lds + (bb) * SHM_V + vst1) = sr_[i].vs1; const int kc = sc * 2;               \
    *(bf16x8*)(K_lds + (bb) * SHM_K + KSWZ(sr, kc)) = sr_[i].ks0;                       \
    *(bf16x8*)(K_lds + (bb) * SHM_K + KSWZ(32 + sr, kc)) = sr_[i].ks1;                  \
    *(bf16x8*)(K_lds + (bb) * SHM_K + KSWZ(rr_, 256 + rc_ * 2)) = sr_[i].kr; } while (0)
#define SWAIT() asm volatile("s_waitcnt vmcnt(0)" ::: "memory")
#define RESC(a) do { if (__any((a) < 1.f)) { if (hi == 0) al_l[r32] = (a); asm volatile("s_waitcnt lgkmcnt(0)" ::: "memory"); \
    _Pragma("unroll") for (int d = 0; d < 4; ++d) _Pragma("unroll") for (int r = 0; r < 16; ++r) o[d][r] *= al_l[crow(r, hi)]; } } while (0)
  f32x16 pA0, pA1, pB0, pB1; float mnA, mnB, alA, alB; bf16x8 pa0, pa1, pa2, pa3; constexpr int NT = (SEQ + CTXL) / KVBLK;
  constexpr int SE = 0, SO = 0;
  SLOAD(SE, 0); asm volatile("s_waitcnt vmcnt(0)" ::: "memory"); SWRITE(0, SE); __syncthreads();
  qkt(pA0, pA1, K_lds, qr, qrl, r32, hi); partialSM(pA0, pA1, m_reg, mnA, alA);
  SLOAD(SO, 1);
  SWAIT(); SWRITE(1, SO); __syncthreads();
  for (int j = 1; j + 1 < NT; j += 2) {
    SBAR(); qkt(pB0, pB1, K_lds + SHM_K, qr, qrl, r32, hi);
    finishSM(pA0, pA1, alA, l_reg, pa0, pa1, pa2, pa3); SBAR();
    SLOAD(SO, j + 1); SBAR();
    pv_d0(o, vb0, pa0, pa1, pa2, pa3); partialSM(pB0, pB1, m_reg, mnB, alB);
    __syncthreads(); SWAIT(); SWRITE(0, SE);
    RESC(alB); __syncthreads();
    SBAR(); qkt(pA0, pA1, K_lds, qr, qrl, r32, hi);
    finishSM(pB0, pB1, alB, l_reg, pa0, pa1, pa2, pa3); SBAR();
    SLOAD(SE, j + 2); SBAR();
    pv_d0(o, vb0 + SHM_V, pa0, pa1, pa2, pa3); partialSM(pA0, pA1, m_reg, mnA, alA);
    __syncthreads(); SWAIT(); SWRITE(1, SO);
    RESC(alA); __syncthreads();
  }
  SBAR(); qkt(pB0, pB1, K_lds + SHM_K, qr, qrl, r32, hi);
  finishSM(pA0, pA1, alA, l_reg, pa0, pa1, pa2, pa3); SBAR();
  pv_d0(o, vb0, pa0, pa1, pa2, pa3); partialSM(pB0, pB1, m_reg, mnB, alB);
  __syncthreads(); RESC(alB);
  finishSM(pB0, pB1, alB, l_reg, pa0, pa1, pa2, pa3); SBAR();
  pv_d0(o, vb0 + SHM_V, pa0, pa1, pa2, pa3);
  if (hi == 0) li_l[r32] = l_reg; asm volatile("s_waitcnt lgkmcnt(0)" ::: "memory");
  float rli[16];
#pragma unroll
  for (int r = 0; r < 16; ++r) rli[r] = __builtin_amdgcn_rcpf(li_l[crow(r, hi)]);
  const long orow0 = qrow0 + wid * QBLK;
#pragma unroll
  for (int r = 0; r < 16; ++r) { const long row = orow0 + crow(r, hi);
#pragma unroll
    for (int d0 = 0; d0 < 4; ++d0) { const int col = h * VH + d0 * 32 + r32;
      const float z = bf2f(Oml[row * LD_Z + col]);
      Oml[row * LD_Z + col] = (bf16_t)f2bf(o[d0][r] * rli[r] * siluf_(z)); } }
  __syncthreads();
#undef TROW
#undef SLOAD
#undef SWRITE
#undef SWAIT
#undef RESC
}
#undef SBAR
}

constexpr int NWAVES = 8, NTHREADS = 512;
constexpr int LDS_BYTES = 147456;
struct Args { const float* in[27]; float* out; unsigned char* ws; int ph_lo, ph_hi; };


__device__ __forceinline__ const float* kin(int i) {
    unsigned long long v; const unsigned long long ka = (unsigned long long)__builtin_amdgcn_kernarg_segment_ptr();
    asm volatile("s_load_dwordx2 %0, %1, %2\n\ts_waitcnt lgkmcnt(0)" : "=s"(v) : "s"(ka), "n"(i * 8) : "memory");
    return (const float*)(const __attribute__((address_space(1))) float*)v;
}

__device__ __forceinline__ void tr_item(const float* __restrict__ W, int ldw, int k0, int n0, bf16_t* __restrict__ WT, int ldd, int drow0, int dcol0,
                                        const float* __restrict__ ksc, LAS float* scr, int lane) {
    float wv[32];
#pragma unroll
    for (int i = 0; i < 32; ++i) wv[i] = __builtin_nontemporal_load(W + (size_t)(k0 + 2 * i + (lane >> 5)) * ldw + n0 + (lane & 31));
#pragma unroll
    for (int i = 0; i < 32; ++i) { const int kk = 2 * i + (lane >> 5); float v = wv[i]; if (ksc) v *= ksc[k0 + kk]; scr[kk * 33 + (lane & 31)] = v; }
    LDS_WAIT(); asm volatile("" ::: "memory");
    const int c = lane & 7;
#pragma unroll
    for (int j = 0; j < 4; ++j) { const int n = (lane >> 3) + 8 * j; const LAS float* s = scr + (8 * c) * 33 + n;
        u32x4 o; o.x = pk2(s[0 * 33], s[1 * 33]); o.y = pk2(s[2 * 33], s[3 * 33]); o.z = pk2(s[4 * 33], s[5 * 33]); o.w = pk2(s[6 * 33], s[7 * 33]);
        *(u32x4*)(WT + (size_t)(drow0 + n) * ldd + dcol0 + k0 + 8 * c) = o; }
    LDS_WAIT(); asm volatile("" ::: "memory");
}
__device__ __forceinline__ int inproj_dst(int n) {
    if (n < 3072) return n;
    if (n < 4096) return n;
    if (n < 4224) return 5888 + (n - 4096);
    if (n < 4352) return 6016 + (n - 4224);
    if (n < 4864) return 5120 + (n - 4352);
    if (n < 5120) return 5632 + (n - 4864);
    if (n < 5184) return 6144 + (n - 5120);
    if (n < 6208) return 4096 + (n - 5184);
    return 6400 + (n - 6208);
}
template <bool LATE> __device__ __forceinline__ void p0_weights(const Args& a, LAS unsigned char* lds, int gw, int NGW, int wave, int lane, int it_lo = 0, int it_hi = 1 << 30) {
    LAS float* scr = (LAS float*)(lds + wave * 16384);
    unsigned char* ws = a.ws;
    constexpr int I_IN = 32 * 322, I_PAD = 192, I_UQ = 8 * 48, I_UKV = 4 * 64, I_BR = 16 * 64, I_OUT = 32 * 64, I_LORA = 128;
    constexpr int NITEMS = I_IN + I_PAD + I_UQ + I_UKV + 2 * I_BR + I_OUT + I_LORA;
    constexpr int N_EARLY = I_IN + I_PAD + I_LORA, N_LATE = I_UQ + I_UKV + 2 * I_BR + I_OUT;
    for (int it = it_lo + gw; it < ((LATE ? N_LATE : N_EARLY) < it_hi ? (LATE ? N_LATE : N_EARLY) : it_hi); it += NGW) {
        int r = LATE ? it + I_IN + I_PAD : (it < I_IN + I_PAD ? it : it + N_LATE);
        if (r < I_IN) { const int kb = r / 322, nb = r % 322; tr_item(kin(7), 10304, 64 * kb, 32 * nb, (bf16_t*)(ws + WS_WIN), DM, inproj_dst(32 * nb), 0, nullptr, scr, lane); continue; } r -= I_IN;
        if (r < I_PAD) {
            const int kb = r / 6, nb = r % 6; bf16_t* d = (bf16_t*)(ws + WS_WIN) + (size_t)(6208 + 32 * nb) * DM + 64 * kb;
#pragma unroll
            for (int j = 0; j < 4; ++j) { const int n = (lane >> 3) + 8 * j; *(u32x4*)(d + (size_t)n * DM + 8 * (lane & 7)) = (u32x4){0u, 0u, 0u, 0u}; }
            continue; } r -= I_PAD;
        if (r < I_UQ) { const int kb = r / 48, nb = r % 48; tr_item(kin(19), 1536, 64 * kb, 32 * nb, (bf16_t*)(ws + WS_WUQ), 512, 32 * nb, 0, kin(18), scr, lane); continue; } r -= I_UQ;
        if (r < I_UKV) { const int kb = r / 64, nb = r % 64; tr_item(kin(21), 2048, 64 * kb, 32 * nb, (bf16_t*)(ws + WS_WUKV), 512, 32 * nb, 0, kin(20), scr, lane); continue; } r -= I_UKV;
        if (r < I_BR) { const int kb = r / 64, nb = r % 64; tr_item(kin(24), 2048, 64 * kb, 32 * nb, (bf16_t*)(ws + WS_WBR), 2048, 32 * nb, 0, nullptr, scr, lane); continue; } r -= I_BR;
        if (r < I_BR) { const int kb = r / 64, nb = r % 64; tr_item(kin(25), 2048, 64 * kb, 32 * nb, (bf16_t*)(ws + WS_WBR), 2048, 32 * nb, 1024, nullptr, scr, lane); continue; } r -= I_BR;
        if (r < I_OUT) { const int kb = r / 64, nb = r % 64; tr_item(kin(26), 2048, 64 * kb, 32 * nb, (bf16_t*)(ws + WS_WOUT), 2048, 32 * nb, 0, nullptr, scr, lane); continue; } r -= I_OUT;
        {
            const int g = r / 32, nb = r % 32; const float* src = (g < 2 ? kin(10) : kin(12)) + (size_t)(g & 1) * 64 * 1024;
            bf16_t* WT = (bf16_t*)(ws + WS_WLORA);
            for (int q = lane; q < 768; q += 64) { const int n = q / 24, ch = q % 24, kc = (ch < g * 8) ? ch : ch + 8;
                *(u32x4*)(WT + (size_t)(g * 1024 + 32 * nb + n) * 256 + kc * 8) = (u32x4){0u, 0u, 0u, 0u}; }
            tr_item(src, 1024, 0, 32 * nb, WT, 256, g * 1024 + 32 * nb, g * 64, nullptr, scr, lane);
        }
    }
}
__device__ __forceinline__ void p0_mod(const Args& a, LAS unsigned char* lds, int vb, int tid) {
    if (vb >= 192) return;
    const float* c = kin(1); const float* cc = kin(3); const float* wm = kin(5); const float* bm = kin(6);
    float* mod = (float*)(a.ws + WS_MOD);
    const int n0 = vb * 32, g = tid & 7, ks = tid >> 3;
    f32x4 acc0 = {0, 0, 0, 0}, acc1 = {0, 0, 0, 0}, acc2 = {0, 0, 0, 0};
#pragma unroll 16
    for (int i = 0; i < 32; ++i) { const int k = ks * 32 + i;
        const f32x4 w = __builtin_nontemporal_load((const f32x4*)(wm + (size_t)k * 6144 + n0 + 4 * g));
        const float s0 = siluf_(c[k]), s1 = siluf_(c[2048 + k]), s2 = siluf_(cc[k]);
        acc0 += w * s0; acc1 += w * s1; acc2 += w * s2; }
    LAS float* red = (LAS float*)lds;
    *(LAS f32x4*)(red + (ks * 3 + 0) * 32 + 4 * g) = acc0; *(LAS f32x4*)(red + (ks * 3 + 1) * 32 + 4 * g) = acc1; *(LAS f32x4*)(red + (ks * 3 + 2) * 32 + 4 * g) = acc2;
    __syncthreads();
    if (tid < 96) { const int v = tid >> 5, col = tid & 31; float s = 0.f;
        for (int k = 0; k < 64; ++k) s += red[(k * 3 + v) * 32 + col];
        mod[v * 6144 + n0 + col] = s + bm[n0 + col]; }
    __syncthreads();
}
__device__ __forceinline__ void p1_hm(const Args& a, LAS unsigned char* lds, int gw, int NGW, int lane) {
    const float* nw = kin(4); const float* mod = (const float*)(a.ws + WS_MOD); bf16_t* hm = (bf16_t*)(a.ws + WS_HM);
    LAS float* tab = (LAS float*)lds; const float* xin = kin(0); const float* cin_ = kin(2);
    { float tn[4], ts[12], th[12];
#pragma unroll
      for (int q = 0; q < 4; ++q) tn[q] = nw[threadIdx.x + q * NTHREADS];
#pragma unroll
      for (int q = 0; q < 12; ++q) { const int i = threadIdx.x + q * NTHREADS, v = i >> 11, c = i & 2047; ts[q] = mod[v * 6144 + 2048 + c]; th[q] = mod[v * 6144 + c]; }
#pragma unroll
      for (int q = 0; q < 12; ++q) { const int i = threadIdx.x + q * NTHREADS, v = i >> 11, c = i & 2047; tab[(v * 2) * 2048 + c] = tn[q & 3] * (1.0f + ts[q]); tab[(v * 2 + 1) * 2048 + c] = th[q]; } }
    __syncthreads();
    for (int m = gw; m < TT; m += NGW) {
        const float* xr; int v;
        if (m < TX) { xr = xin + (size_t)m * DM; v = m / SEQ; } else { xr = cin_ + (size_t)(m - TX) * DM; v = 2; }
        f32x4 xv[8]; float ss = 0.f;
#pragma unroll
        for (int j = 0; j < 8; ++j) { xv[j] = __builtin_nontemporal_load((const f32x4*)(xr + 4 * (lane + 64 * j))); ss += (xv[j][0] * xv[j][0] + xv[j][1] * xv[j][1]) + (xv[j][2] * xv[j][2] + xv[j][3] * xv[j][3]); }
        const float rstd = rsqrtf(wave_sum(ss) * (1.f / DM) + EPS);
#pragma unroll
        for (int j = 0; j < 8; ++j) { const int c0 = 4 * (lane + 64 * j);
            const f32x4 gn = *(const LAS f32x4*)(tab + (v * 2) * 2048 + c0), sh = *(const LAS f32x4*)(tab + (v * 2 + 1) * 2048 + c0);
            const f32x4 y = (xv[j] * rstd) * gn + sh;
            u32x2 o; o.x = cvt_pk_bf16(y[0], y[1]); o.y = cvt_pk_bf16(y[2], y[3]);
            *(u32x2*)(hm + (size_t)m * DM + c0) = o; }
    }
}

__device__ __forceinline__ void unpack8(const u32x4 w, float* f) { f[0] = bflo(w.x); f[1] = bfhi(w.x); f[2] = bflo(w.y); f[3] = bfhi(w.y); f[4] = bflo(w.z); f[5] = bfhi(w.z); f[6] = bflo(w.w); f[7] = bfhi(w.w); }
__device__ __forceinline__ u32x4 pack8(const float* f) { u32x4 w; w.x = pk2(f[0], f[1]); w.y = pk2(f[2], f[3]); w.z = pk2(f[4], f[5]); w.w = pk2(f[6], f[7]); return w; }
__device__ __forceinline__ u32x4 pack8c(const float* f) { u32x4 w; w.x = cvt_pk_bf16(f[0], f[1]); w.y = cvt_pk_bf16(f[2], f[3]); w.z = cvt_pk_bf16(f[4], f[5]); w.w = cvt_pk_bf16(f[6], f[7]); return w; }
__device__ __forceinline__ float sum8sq(const float* f) { return ((f[0] * f[0] + f[1] * f[1]) + (f[2] * f[2] + f[3] * f[3])) + ((f[4] * f[4] + f[5] * f[5]) + (f[6] * f[6] + f[7] * f[7])); }
__device__ __forceinline__ float red8(float v) { v += __shfl_xor(v, 1); v += __shfl_xor(v, 2); v += __shfl_xor(v, 4); return v; }

namespace cs {
constexpr int RS = 144, SLOT = 64 * RS, NCHUNK = 132, NSEG = 4, CPS = NCHUNK / NSEG;
enum { S_KKD = 0, S_RD = 1, S_KINV = 2, S_AKINV = 3, S_NAKBT = 4, S_KKDT = 5, S_KBART = 6, S_VT = 7, S_AAKT = 8, S_AQK = 9, S_NAQA = 10, S_N = 11, S_NT = 12, S_F2 = 13, S_ST = 14,
       S_NB = 0, S_NBT = 2, S_F1 = 3, S_G1 = 11, S_G2 = 12, S_P = 0, S_RW = 2, S_M2 = 13, S_M4 = 3, S_PACC = 9 };
constexpr int OFF_WTOT = 15 * SLOT, OFF_GC = OFF_WTOT + 8 * 64 * 4, OFF_RN = OFF_GC + 256, OFF_LWW = S_N * SLOT, OFF_LWA = S_KKD * SLOT, OFF_RED1 = S_KINV * SLOT, OFF_RED2 = S_NAKBT * SLOT;
static_assert(OFF_RN + 8 * 8 * 4 <= 147456 - 256, "chunk scan LDS map");
#define CS_AR(s) (lds + (s) * cs::SLOT)
#define CS_BAR() asm volatile("s_waitcnt lgkmcnt(0)\n\ts_barrier" ::: "memory")

template <int KS0, int KS1> __device__ __forceinline__ f32x16 tile_nt(f32x16 acc, const LAS unsigned char* X, int m0, const LAS unsigned char* Y, int n0, int r32, int hi) {
#pragma unroll
    for (int ks = KS0; ks < KS1; ++ks) {
        const bf16x8 a = *(const LAS bf16x8*)(X + (m0 + r32) * RS + ks * 32 + hi * 16);
        const bf16x8 b = *(const LAS bf16x8*)(Y + (n0 + r32) * RS + ks * 32 + hi * 16);
        acc = __builtin_amdgcn_mfma_f32_32x32x16_bf16(a, b, acc, 0, 0, 0);
    }
    return acc;
}
__device__ __forceinline__ f32x16 tile_rng(int range, f32x16 acc, const LAS unsigned char* X, int m0, const LAS unsigned char* Y, int n0, int r32, int hi) {
    if (range == 0) return tile_nt<0, 4>(acc, X, m0, Y, n0, r32, hi);
    if (range == 1) return tile_nt<0, 2>(acc, X, m0, Y, n0, r32, hi);
    return tile_nt<2, 4>(acc, X, m0, Y, n0, r32, hi);
}
__device__ __forceinline__ void tile2_nt(f32x16& a0, const LAS unsigned char* X0, int m00, const LAS unsigned char* Y0, int n00, f32x16& a1, const LAS unsigned char* X1, int m01, const LAS unsigned char* Y1, int n01, int r32, int hi) {
#pragma unroll
    for (int ks = 0; ks < 4; ++ks) {
        const bf16x8 xa = *(const LAS bf16x8*)(X0 + (m00 + r32) * RS + ks * 32 + hi * 16), ya = *(const LAS bf16x8*)(Y0 + (n00 + r32) * RS + ks * 32 + hi * 16);
        const bf16x8 xb = *(const LAS bf16x8*)(X1 + (m01 + r32) * RS + ks * 32 + hi * 16), yb = *(const LAS bf16x8*)(Y1 + (n01 + r32) * RS + ks * 32 + hi * 16);
        a0 = __builtin_amdgcn_mfma_f32_32x32x16_bf16(xa, ya, a0, 0, 0, 0); a1 = __builtin_amdgcn_mfma_f32_32x32x16_bf16(xb, yb, a1, 0, 0, 0);
    }
}
__device__ __forceinline__ void tile3_nt(f32x16& a0, const LAS unsigned char* X0, const LAS unsigned char* Y0, f32x16& a1, const LAS unsigned char* X1, const LAS unsigned char* Y1,
                                         f32x16& a2, const LAS unsigned char* X2, const LAS unsigned char* Y2, int m0, int n0, int r32, int hi) {
#pragma unroll
    for (int ks = 0; ks < 4; ++ks) { const int xo = (m0 + r32) * RS + ks * 32 + hi * 16, yo = (n0 + r32) * RS + ks * 32 + hi * 16;
        a0 = __builtin_amdgcn_mfma_f32_32x32x16_bf16(*(const LAS bf16x8*)(X0 + xo), *(const LAS bf16x8*)(Y0 + yo), a0, 0, 0, 0);
        a1 = __builtin_amdgcn_mfma_f32_32x32x16_bf16(*(const LAS bf16x8*)(X1 + xo), *(const LAS bf16x8*)(Y1 + yo), a1, 0, 0, 0);
        a2 = __builtin_amdgcn_mfma_f32_32x32x16_bf16(*(const LAS bf16x8*)(X2 + xo), *(const LAS bf16x8*)(Y2 + yo), a2, 0, 0, 0); }
}
__device__ __forceinline__ void tile_diag_pair(f32x16& a0, f32x16& a1, const LAS unsigned char* X, const LAS unsigned char* Y, int r32, int hi) {
#pragma unroll
    for (int ks = 0; ks < 2; ++ks) {
        a0 = __builtin_amdgcn_mfma_f32_32x32x16_bf16(*(const LAS bf16x8*)(X + r32 * RS + ks * 32 + hi * 16), *(const LAS bf16x8*)(Y + r32 * RS + ks * 32 + hi * 16), a0, 0, 0, 0);
        a1 = __builtin_amdgcn_mfma_f32_32x32x16_bf16(*(const LAS bf16x8*)(X + (32 + r32) * RS + (ks + 2) * 32 + hi * 16), *(const LAS bf16x8*)(Y + (32 + r32) * RS + (ks + 2) * 32 + hi * 16), a1, 0, 0, 0);
    }
}
__device__ __forceinline__ void store_nat(LAS unsigned char* E, int m0, int n0, const f32x16& d, int r32, int hi) {
#pragma unroll
    for (int g = 0; g < 4; ++g) { u32x2 w; w.x = cvt_pk_bf16(d[4 * g], d[4 * g + 1]); w.y = cvt_pk_bf16(d[4 * g + 2], d[4 * g + 3]);
        *(LAS u32x2*)(E + (n0 + r32) * RS + (m0 + 8 * g + 4 * hi) * 2) = w; }
}
__device__ __forceinline__ void store_nat_g(bf16_t* E, int m0, int n0, const f32x16& d, int r32, int hi) {
#pragma unroll
    for (int g = 0; g < 4; ++g) { u32x2 w; w.x = cvt_pk_bf16(d[4 * g], d[4 * g + 1]); w.y = cvt_pk_bf16(d[4 * g + 2], d[4 * g + 3]);
        *(u32x2*)(E + (n0 + r32) * 64 + (m0 + 8 * g + 4 * hi)) = w; }
}
__device__ __forceinline__ void store_zero(LAS unsigned char* E, int m0, int n0, int r32, int hi) {
#pragma unroll
    for (int g = 0; g < 4; ++g) *(LAS u32x2*)(E + (n0 + r32) * RS + (m0 + 8 * g + 4 * hi) * 2) = (u32x2){0u, 0u};
}
__device__ __forceinline__ void add_nat(f32x16& d, const LAS unsigned char* E, int m0, int n0, int r32, int hi) {
#pragma unroll
    for (int g = 0; g < 4; ++g) { const u32x2 w = *(const LAS u32x2*)(E + (n0 + r32) * RS + (m0 + 8 * g + 4 * hi) * 2);
        d[4 * g] += bflo(w.x); d[4 * g + 1] += bfhi(w.x); d[4 * g + 2] += bflo(w.y); d[4 * g + 3] += bfhi(w.y); }
}
template <int MODE, bool NEG> __device__ __forceinline__ void mask_tile(f32x16& d, int m0, int n0, int r32, int hi) {
    const int n = n0 + r32;
#pragma unroll
    for (int r = 0; r < 16; ++r) { const int m = m0 + (r & 3) + 8 * (r >> 2) + 4 * hi;
        const bool keep = MODE == 0 ? (n < m) : (MODE == 1 ? (m <= n) : (m < n));
        d[r] = keep ? (NEG ? -d[r] : d[r]) : 0.f; }
}
template <int CTRL> __device__ __forceinline__ float dpp_addf(float v) { return v + __int_as_float(__builtin_amdgcn_update_dpp(0, __float_as_int(v), CTRL, 0xF, 0xF, true)); }
__device__ __forceinline__ float sum_oct(float v) { v = dpp_addf<0xB1>(v); v = dpp_addf<0x4E>(v); v = dpp_addf<0x141>(v); return v; }

__device__ __forceinline__ void g2l(LAS unsigned char* slot, const bf16_t* g, int tid) { *(LAS u32x4*)(slot + (tid >> 3) * RS + (tid & 7) * 16) = *(const u32x4*)(g + (tid >> 3) * 64 + (tid & 7) * 8); }
__device__ __forceinline__ void l2g(bf16_t* g, const LAS unsigned char* slot, int tid) { *(u32x4*)(g + (tid >> 3) * 64 + (tid & 7) * 8) = *(const LAS u32x4*)(slot + (tid >> 3) * RS + (tid & 7) * 16); }

struct Chain { int d, b, h; };
struct ChainConst { float cw[3][3], w0c, a0c, kkc, kac, rkc; bf16x8 wl[4]; };
struct Prefetch { u32x4 xq[4]; bf16x8 lx[4]; };
__device__ __forceinline__ int tok_row(const Chain& ch, int c, int t) {
    const int s = c * 64 + t;
    if (s < CTXL) return TX + ch.b * CTXL + (ch.d ? (CTXL - 1 - s) : s);
    const int u = s - CTXL; return ch.b * SEQ + (ch.d ? (SEQ - 1 - u) : u);
}
__device__ __forceinline__ void wave_geom(const Chain& ch, int c, int wave, int& rowbase, int& seqlen, int& tmin) {
    const int s0 = c * 64 + wave * 8; int tfirst;
    if (s0 < CTXL) { seqlen = CTXL; rowbase = TX + ch.b * CTXL; tfirst = ch.d ? (CTXL - 1 - s0) : s0; }
    else { const int u = s0 - CTXL; seqlen = SEQ; rowbase = ch.b * SEQ; tfirst = ch.d ? (SEQ - 1 - u) : u; }
    tmin = ch.d ? tfirst - 7 : tfirst;
}
__device__ __forceinline__ void pf_issue(Prefetch& pf, unsigned char* ws, const Chain& ch, int c, int wave, int lane) {
    const bf16_t* Urkv = (const bf16_t*)(ws + WS_URKV); const bf16_t* Usm = (const bf16_t*)(ws + WS_USM);
    int rowbase, seqlen, tmin; wave_geom(ch, c, wave, rowbase, seqlen, tmin);
#pragma unroll
    for (int k = 0; k < 4; ++k) { const int q = lane + 64 * k, i = q / 24, rem = q - 24 * i, e = rem >> 3, c8 = rem & 7;
        const int t = tmin - 1 + i; const bool ok = (t >= 0) && (t < seqlen);
        if (q < 240) pf.xq[k] = *(const u32x4*)(Urkv + (size_t)(rowbase + (ok ? t : tmin)) * LD_RKV + e * 1024 + ch.h * 64 + c8 * 8); }
    const int type = wave >> 2, mi = (wave >> 1) & 1, r32 = lane & 31, hi = lane >> 5;
    const bf16_t* xp = Usm + (size_t)tok_row(ch, c, 32 * mi + r32) * LD_SM + 768 + type * 128 + ch.d * 64 + hi * 8;
#pragma unroll
    for (int ks = 0; ks < 4; ++ks) pf.lx[ks] = *(const bf16x8*)(xp + ks * 16);
}

__device__ __forceinline__ void l0_lora(LAS unsigned char* lds, const Prefetch& pf, const ChainConst& cc, int wave, int lane) {
    const int r32 = lane & 31, hi = lane >> 5, type = wave >> 2, mi = (wave >> 1) & 1, ni = wave & 1;
    f32x16 acc = {};
#pragma unroll
    for (int ks = 0; ks < 4; ++ks) acc = __builtin_amdgcn_mfma_f32_32x32x16_bf16(pf.lx[ks], cc.wl[ks], acc, 0, 0, 0);
    LAS float* o = (LAS float*)(lds + (type ? OFF_LWA : OFF_LWW));
#pragma unroll
    for (int r = 0; r < 16; ++r) o[(32 * mi + (r & 3) + 8 * (r >> 2) + 4 * hi) * 64 + 32 * ni + r32] = acc[r];
}

__device__ __forceinline__ void s1_factors(float (&f)[16], int p, int k, int r32, int hi) {
    const bool lw = (p == 0 || p == 4); const int m0 = k == 0 ? 0 : (k == 1 ? 32 : (lw ? 32 : 0)), n0 = k == 0 ? 0 : (k == 1 ? 32 : (lw ? 0 : 32));
    const int a = (p == 0 || p == 4) ? 1 : -1, b = (p == 1 || p == 2) ? 1 : 0; const float sg = (p == 0 || p == 1) ? 1.0f : -1.0f; const int n = n0 + r32;
#pragma unroll
    for (int r = 0; r < 16; ++r) { const int m = m0 + (r & 3) + 8 * (r >> 2) + 4 * hi; int t = a * (m - n) + b; t = t < 0 ? 0 : (t > 1 ? 1 : t); f[r] = sg * (float)t; }
}
template <int DD> __device__ __forceinline__ void chunk(LAS unsigned char* lds, unsigned char* ws, const Chain ch_, const ChainConst& cc, Prefetch& pf, int c, int c_end, int tid, int wave_, int lane_, const float (&mfa)[16], const float (&mfb)[16], const float (&dfac)[16]) {
    Chain ch = ch_; ch.d = DD;
    constexpr bool PASSB = true;
    int wave = wave_, lane = lane_; asm volatile("" : "+s"(wave), "+v"(lane));
    const int r32 = lane & 31, hi = lane >> 5;
    const bool latent = c >= CTXL / 64;
    float rr[8], kkv[8], kmv[8], akv[8], vv[8], lgw[8], cum[8];
    int rowbase, seqlen, tmin; wave_geom(ch, c, wave, rowbase, seqlen, tmin);
    {
        LAS float* red1 = (LAS float*)(lds + OFF_RED1) + wave * 512; LAS float* red2 = (LAS float*)(lds + OFF_RED2) + wave * 512;
        LAS unsigned char* stg = lds + S_KBART * SLOT + wave * 3840;
#pragma unroll
        for (int k = 0; k < 4; ++k) if (lane + 64 * k < 240) *(LAS u32x4*)(stg + (lane + 64 * k) * 16) = pf.xq[k];
        asm volatile("s_waitcnt lgkmcnt(0)" ::: "memory");
        float x[10][3];
#pragma unroll
        for (int i = 0; i < 10; ++i)
#pragma unroll
            for (int e = 0; e < 3; ++e) x[i][e] = bf2f(*(const LAS bf16_t*)(stg + ((i * 3 + e) * 64 + lane) * 2));
        if (tmin == 0) { x[0][0] = 0.f; x[0][1] = 0.f; x[0][2] = 0.f; }
        if (tmin + 8 == seqlen) { x[9][0] = 0.f; x[9][1] = 0.f; x[9][2] = 0.f; }
#pragma unroll
        for (int jj = 0; jj < 8; ++jj) {
            rr[jj] = cc.cw[0][0] * x[jj][0] + cc.cw[1][0] * x[jj + 1][0] + cc.cw[2][0] * x[jj + 2][0];
            const float k = cc.cw[0][1] * x[jj][1] + cc.cw[1][1] * x[jj + 1][1] + cc.cw[2][1] * x[jj + 2][1];
            vv[jj] = cc.cw[0][2] * x[jj][2] + cc.cw[1][2] * x[jj + 1][2] + cc.cw[2][2] * x[jj + 2][2];
            kmv[jj] = k; kkv[jj] = k * cc.kkc; red1[jj * 64 + lane] = kkv[jj] * kkv[jj];
        }
        const LAS float* lww = (const LAS float*)(lds + OFF_LWW); const LAS float* lwa = (const LAS float*)(lds + OFF_LWA);
#pragma unroll
        for (int jj = 0; jj < 8; ++jj) {
            const int tl = wave * 8 + (ch.d ? 7 - jj : jj);
            lgw[jj] = -0.6065306597126334f * fast_sigmoid(cc.w0c + lww[tl * 64 + lane]);
            const float a = fast_sigmoid(cc.a0c + lwa[tl * 64 + lane]);
            const float k = kmv[jj]; kmv[jj] = k * (1.0f + (a - 1.0f) * cc.kac); akv[jj] = a * kkv[jj];
            if (PASSB) red2[jj * 64 + lane] = rr[jj] * kmv[jj] * cc.rkc;
        }
        asm volatile("s_waitcnt lgkmcnt(0)" ::: "memory");
        { const int tk = lane >> 3, cg = lane & 7; const f32x4 q0 = *(const LAS f32x4*)(red1 + tk * 64 + cg * 8), q1 = *(const LAS f32x4*)(red1 + tk * 64 + cg * 8 + 4);
          const float ss = sum_oct(((q0[0] + q0[1]) + (q0[2] + q0[3])) + ((q1[0] + q1[1]) + (q1[2] + q1[3])));
          LAS float* rnl = (LAS float*)(lds + OFF_RN) + wave * 8; if (cg == 0) rnl[tk] = rsqrtf(ss + 1e-12f);
          if (PASSB && latent) { const f32x4 p0 = *(const LAS f32x4*)(red2 + tk * 64 + cg * 8), p1 = *(const LAS f32x4*)(red2 + tk * 64 + cg * 8 + 4);
              const float cf = sum_oct(((p0[0] + p0[1]) + (p0[2] + p0[3])) + ((p1[0] + p1[1]) + (p1[2] + p1[3])));
              if (cg == 0) ((float*)(ws + WS_COEF))[((size_t)ch.d * TX + rowbase + tmin + tk) * 16 + ch.h] = cf; }
          asm volatile("s_waitcnt lgkmcnt(0)" ::: "memory");
          const f32x4 n0 = *(const LAS f32x4*)rnl, n1 = *(const LAS f32x4*)(rnl + 4);
#pragma unroll
          for (int jj = 0; jj < 8; ++jj) { const float rn = jj < 4 ? n0[jj & 3] : n1[jj & 3]; kkv[jj] *= rn; akv[jj] *= rn; } }
        if (ch.d) { float s = 0.f;
#pragma unroll
            for (int jj = 7; jj >= 0; --jj) { s += lgw[jj]; cum[jj] = s; } ((LAS float*)(lds + OFF_WTOT))[wave * 64 + lane] = s; }
        else { float s = 0.f;
#pragma unroll
            for (int jj = 0; jj < 8; ++jj) { s += lgw[jj]; cum[jj] = s; } ((LAS float*)(lds + OFF_WTOT))[wave * 64 + lane] = s; }
    }
    CS_BAR();
    {
        const LAS float* wt = (const LAS float*)(lds + OFF_WTOT);
        float pre = 0.f, tot = 0.f;
#pragma unroll
        for (int w = 0; w < 8; ++w) { const float v = wt[w * 64 + lane]; tot += v; pre += (w < wave) ? v : 0.f; }
        if (wave == 0) ((LAS float*)(lds + OFF_GC))[lane] = __expf(tot);
        float kkdT[8], nakT[8], kbT[8], vT[8];
        float e2v[8]; const float epre = __expf(pre), etot = __expf(tot);
#pragma unroll
        for (int jj = 0; jj < 8; ++jj) e2v[jj] = __expf(pre + cum[jj]);
#pragma unroll
        for (int jj = 0; jj < 8; ++jj) {
            const int i = ch.d ? 7 - jj : jj, t = wave * 8 + i;
            const float e2 = e2v[jj], e1 = ch.d ? (jj == 7 ? epre : e2v[jj == 7 ? 7 : jj + 1]) : (jj == 0 ? epre : e2v[jj == 0 ? 0 : jj - 1]), e3 = __builtin_amdgcn_rcpf(e2), e4 = etot * e3;
            const float kkd = kkv[jj] * e1;
            *(LAS bf16_t*)(CS_AR(S_KKD) + t * RS + lane * 2) = (bf16_t)cvt_pk_bf16(kkd, 0.f);
            *(LAS bf16_t*)(CS_AR(S_RD) + t * RS + lane * 2) = (bf16_t)cvt_pk_bf16(rr[jj] * e2, 0.f);
            *(LAS bf16_t*)(CS_AR(S_KINV) + t * RS + lane * 2) = (bf16_t)cvt_pk_bf16(kmv[jj] * e3, 0.f);
            *(LAS bf16_t*)(CS_AR(S_AKINV) + t * RS + lane * 2) = (bf16_t)cvt_pk_bf16(akv[jj] * e3, 0.f);
            if (ch.d) { kkdT[7 - jj] = kkd; nakT[7 - jj] = -akv[jj] * e4; kbT[7 - jj] = kmv[jj] * e4; vT[7 - jj] = vv[jj]; }
            else { kkdT[jj] = kkd; nakT[jj] = -akv[jj] * e4; kbT[jj] = kmv[jj] * e4; vT[jj] = vv[jj]; }
        }
        *(LAS u32x4*)(CS_AR(S_KKDT) + lane * RS + wave * 16) = pack8c(kkdT); *(LAS u32x4*)(CS_AR(S_NAKBT) + lane * RS + wave * 16) = pack8c(nakT);
        *(LAS u32x4*)(CS_AR(S_KBART) + lane * RS + wave * 16) = pack8c(kbT); *(LAS u32x4*)(CS_AR(S_VT) + lane * RS + wave * 16) = pack8c(vT);
    }
    if (c + 1 < c_end) pf_issue(pf, ws, ch, c + 1, wave, lane);
    CS_BAR();
    {
        constexpr int NTASK = PASSB ? 15 : 9;
        int pA, kA, pB, kB; { const int t0 = 2 * wave, t1 = 2 * wave + 1; pA = t0 / 3; kA = t0 % 3; pB = t1 / 3; kB = t1 % 3; if (!PASSB) { if (pA >= 1) pA += 2; if (pB >= 1) pB += 2; } }
        const bool doA = 2 * wave < NTASK, doB = 2 * wave + 1 < NTASK;
#define S1_GEOM(p, k, m0, n0, sx, sy, so) const bool lw_##m0 = ((p) == 0 || (p) == 4); const int m0 = (k) == 0 ? 0 : ((k) == 1 ? 32 : (lw_##m0 ? 32 : 0)), n0 = (k) == 0 ? 0 : ((k) == 1 ? 32 : (lw_##m0 ? 0 : 32)); \
        const int sx = ((p) == 0 || (p) == 4) ? S_KKD : ((p) == 1 ? S_KINV : S_AKINV), sy = (p) == 0 ? S_KINV : ((p) == 4 ? S_AKINV : ((p) == 3 ? S_KKD : S_RD)), so = (p) == 0 ? S_AAKT : ((p) == 1 ? S_AQK : ((p) == 2 ? S_NAQA : ((p) == 3 ? S_N : S_NT)));
#define S1_FIN(p, acc, m0, n0, so, F) do { _Pragma("unroll") for (int r_ = 0; r_ < 16; ++r_) acc[r_] *= F[r_];         \
            store_nat(CS_AR(so), m0, n0, acc, r32, hi); if ((p) == 4) store_nat(CS_AR(S_F2), m0, n0, acc, r32, hi); \
            if ((p) == 3 && (m0) == 32 && (n0) == 32) store_nat(CS_AR(S_ST), 0, 32, acc, r32, hi); } while (0)
        if (doA) {
            S1_GEOM(pA, kA, mA, nA, sxA, syA, soA) S1_GEOM(pB, kB, mB, nB, sxB, syB, soB)
            f32x16 a0 = {}, a1 = {};
            if (doB) { tile2_nt(a0, CS_AR(sxA), mA, CS_AR(syA), nA, a1, CS_AR(sxB), mB, CS_AR(syB), nB, r32, hi); S1_FIN(pA, a0, mA, nA, soA, mfa); S1_FIN(pB, a1, mB, nB, soB, mfb); }
            else { a0 = tile_nt<0, 4>(a0, CS_AR(sxA), mA, CS_AR(syA), nA, r32, hi); S1_FIN(pA, a0, mA, nA, soA, mfa); }
        }
        if (wave == 7) {
            store_zero(CS_AR(S_AAKT), 0, 32, r32, hi); store_zero(CS_AR(S_N), 32, 0, r32, hi); store_zero(CS_AR(S_NT), 0, 32, r32, hi); store_zero(CS_AR(S_F2), 0, 32, r32, hi);
            if (PASSB) { store_zero(CS_AR(S_AQK), 32, 0, r32, hi); store_zero(CS_AR(S_NAQA), 32, 0, r32, hi); } }
#undef S1_GEOM
#undef S1_FIN
    }
    CS_BAR();
    {
        const int bI = wave >> 2, jI = wave & 3, r0 = 32 * bI, k0 = 2 * bI;
#define T32(acc, X, xr, xk, Y, yr, yk) do { _Pragma("unroll") for (int ks = 0; ks < 2; ++ks) acc = __builtin_amdgcn_mfma_f32_32x32x16_bf16( \
            *(const LAS bf16x8*)(CS_AR(X) + ((xr) + r32) * RS + ((xk) + ks) * 32 + hi * 16), *(const LAS bf16x8*)(CS_AR(Y) + ((yr) + r32) * RS + ((yk) + ks) * 32 + hi * 16), acc, 0, 0, 0); } while (0)
#define ADD_I(acc) do { _Pragma("unroll") for (int r = 0; r < 16; ++r) acc[r] += dfac[r]; } while (0)
#define WWAIT() asm volatile("s_waitcnt lgkmcnt(0)" ::: "memory")
#define INV_IT(XN, XNT, ON, ONT, DOSQ, PN, PNT, FI, FO, EI, EIr, EIk, EO, DOF, LASTI) do { \
            if (DOSQ && jI == 0) { f32x16 d1 = {}; T32(d1, XN, r0, k0, XNT, r0, k0); store_nat(CS_AR(ONT), r0, r0, d1, r32, hi); } \
            if (DOSQ && jI == 1) { f32x16 d2 = {}; T32(d2, XNT, r0, k0, XN, r0, k0); store_nat(CS_AR(ON), r0, r0, d2, r32, hi); } \
            if (DOF && jI == 2) { f32x16 df = {}; T32(df, PN, r0, k0, FI, r0, k0); add_nat(df, CS_AR(FI), r0, r0, r32, hi); add_nat(df, CS_AR(PNT), r0, r0, r32, hi); if (LASTI) ADD_I(df); \
                store_nat(CS_AR(FO), r0, r0, df, r32, hi); } \
            if (DOF && wave == 7) { f32x16 de = {}; T32(de, PNT, r0, k0, EI, EIr, EIk); add_nat(de, CS_AR(EI), 16 * (EIk), EIr, r32, hi); add_nat(de, CS_AR(PN), r0, r0, r32, hi); if (LASTI) ADD_I(de); \
                store_nat(CS_AR(EO), 0, 32, de, r32, hi); } \
            CS_BAR(); } while (0)
        INV_IT(S_N, S_NT, S_NB, S_NBT, true, 0, 0, 0, 0, 0, 0, 0, 0, false, false);
        INV_IT(S_NB, S_NBT, S_N, S_NT, true, S_NB, S_NBT, S_F2, S_F1, S_ST, 32, 0, S_NB, true, false);
        INV_IT(S_N, S_NT, S_NB, S_NBT, true, S_N, S_NT, S_F1, S_F2, S_NB, 32, 0, S_NBT, true, false);
        INV_IT(S_NB, S_NBT, S_N, S_NT, true, S_NB, S_NBT, S_F2, S_F1, S_NBT, 32, 0, S_NB, true, false);
        INV_IT(0, 0, 0, 0, false, S_N, S_NT, S_F1, S_F2, S_NB, 32, 0, S_NBT, true, true);
    }
    if (wave == 1) {
        f32x16 z = {}; T32(z, S_N, 32, 0, S_F2, 0, 0); store_nat(CS_AR(S_F1), 32, 0, z, r32, hi); WWAIT();
        f32x16 t = {}; T32(t, S_NBT, 32, 0, S_F1, 0, 2); store_nat(CS_AR(S_F2), 32, 0, t, r32, hi);
    }
    CS_BAR();
#undef T32
#undef ADD_I
#undef WWAIT
#undef INV_IT
    { const int p = wave >> 2, m0 = ((wave >> 1) & 1) * 32, n0 = (wave & 1) * 32; f32x16 acc = {};
      if (p == 0) { acc = tile_nt<0, 4>(acc, CS_AR(S_F2), m0, CS_AR(S_NAKBT), n0, r32, hi); store_nat(CS_AR(S_G1), m0, n0, acc, r32, hi); }
      else if (PASSB) { if (m0 == 32 && n0 == 0) store_zero(CS_AR(S_G2), m0, n0, r32, hi);
          else { acc = tile_nt<0, 4>(acc, CS_AR(S_F2), m0, CS_AR(S_NAQA), n0, r32, hi); store_nat(CS_AR(S_G2), m0, n0, acc, r32, hi); } } }
    CS_BAR();
    bf16_t* rec = (bf16_t*)(ws + WS_SCAN) + ((size_t)((ch.d * 2 + ch.b) * 16 + ch.h) * NCHUNK + c) * (4 * 4096);
    asm volatile("" :: "v"(pf.xq[0]), "v"(pf.xq[1]), "v"(pf.xq[2]), "v"(pf.xq[3]), "v"(pf.lx[0]), "v"(pf.lx[1]), "v"(pf.lx[2]), "v"(pf.lx[3]));
    { const int q = wave >> 2, m0 = ((wave >> 1) & 1) * 32, n0 = (wave & 1) * 32;
      if (q == 0) {
          f32x16 a0 = {}, a1 = {}; tile2_nt(a0, CS_AR(S_KKDT), m0, CS_AR(S_G1), n0, a1, CS_AR(S_AAKT), m0, CS_AR(S_G1), n0, r32, hi);
          if (m0 == n0) { const float gc = ((const LAS float*)(lds + OFF_GC))[n0 + r32];
#pragma unroll
              for (int r = 0; r < 16; ++r) a0[r] += gc * dfac[r]; }
          store_nat_g(rec, m0, n0, a0, r32, hi); store_nat(CS_AR(S_M2), m0, n0, a1, r32, hi);
      } else if (PASSB) {
          f32x16 a0 = {}, a1 = {}; tile2_nt(a0, CS_AR(S_KKDT), m0, CS_AR(S_G2), n0, a1, CS_AR(S_AAKT), m0, CS_AR(S_G2), n0, r32, hi);
          add_nat(a0, CS_AR(S_RD), m0, n0, r32, hi); store_nat_g(rec + 4096, m0, n0, a0, r32, hi); store_nat(CS_AR(S_M4), m0, n0, a1, r32, hi);
      } }
    CS_BAR();
    { const int p = wave >> 2, m0 = ((wave >> 1) & 1) * 32, n0 = (wave & 1) * 32; f32x16 a0 = {}, a1 = {};
      if (p == 0) {
          tile2_nt(a0, CS_AR(S_KBART), m0, CS_AR(S_VT), n0, a1, CS_AR(S_M2), m0, CS_AR(S_VT), n0, r32, hi); a0 = a0 + a1;
          store_nat_g(rec + 8192, m0, n0, a0, r32, hi);
      } else if (latent) {
          tile2_nt(a0, CS_AR(S_AQK), m0, CS_AR(S_VT), n0, a1, CS_AR(S_M4), m0, CS_AR(S_VT), n0, r32, hi); a0 = a0 + a1;
          store_nat_g(rec + 12288, m0, n0, a0, r32, hi);
      } }
    if (c + 1 < c_end) l0_lora(lds, pf, cc, wave, lane);
    CS_BAR();
}

template <int DD> __device__ __forceinline__ void scan_stage1_dir(LAS unsigned char* lds, unsigned char* ws, int unit, int tid, int wave, int lane) {
    const int chain = (unit & 7) * 8 + ((unit >> 3) >> 2), seg = (unit >> 3) & 3;
    const Chain ch{DD, (chain >> 4) & 1, chain & 15};
    const int r32 = lane & 31, hi = lane >> 5;
    ChainConst cc;
    { const int chn = ch.h * 64 + lane; const float* cwp = kin(8);
#pragma unroll
      for (int t = 0; t < 3; ++t)
#pragma unroll
          for (int e = 0; e < 3; ++e) cc.cw[t][e] = cwp[t * 3072 + e * 1024 + chn];
      cc.w0c = kin(9)[ch.d * 1024 + chn]; cc.a0c = kin(11)[ch.d * 1024 + chn]; cc.kkc = kin(13)[chn]; cc.kac = kin(14)[chn]; cc.rkc = kin(15)[chn];
      const int type = wave >> 2, ni = wave & 1, g = type * 2 + ch.d;
      const bf16_t* yp = (const bf16_t*)(ws + WS_WLORA) + (size_t)(g * 1024 + ch.h * 64 + 32 * ni + r32) * 256 + g * 64 + hi * 8;
#pragma unroll
      for (int ks = 0; ks < 4; ++ks) cc.wl[ks] = *(const bf16x8*)(yp + ks * 16); }
    Prefetch pf; pf_issue(pf, ws, ch, seg * CPS, wave, lane);
    l0_lora(lds, pf, cc, wave, lane); CS_BAR();
    float mfa[16], mfb[16], dfac[16];
    { const int t0 = 2 * wave, t1 = 2 * wave + 1; s1_factors(mfa, t0 / 3, t0 % 3, r32, hi); s1_factors(mfb, t1 / 3, t1 % 3, r32, hi);
#pragma unroll
      for (int r = 0; r < 16; ++r) { int t = (r & 3) + 8 * (r >> 2) + 4 * hi - r32; t = t < 0 ? -t : t; t = 1 - (t > 1 ? 1 : t); dfac[r] = (float)t; } }
    for (int c = seg * CPS; c < (seg + 1) * CPS; ++c) chunk<DD>(lds, ws, ch, cc, pf, c, (seg + 1) * CPS, tid, wave, lane, mfa, mfb, dfac);
}
__device__ __forceinline__ void scan_stage1(LAS unsigned char* lds, unsigned char* ws, int unit, int tid, int wave, int lane) {
    const int chain = (unit & 7) * 8 + ((unit >> 3) >> 2);
    if (chain >> 5) scan_stage1_dir<1>(lds, ws, unit, tid, wave, lane); else scan_stage1_dir<0>(lds, ws, unit, tid, wave, lane);
}

__device__ __forceinline__ void scan_stage2(LAS unsigned char* lds, unsigned char* ws, int chain, int iq, int tid, int wave, int lane) {
    unsigned char* recs = ws + WS_SCAN + (size_t)chain * NCHUNK * REC_BYTES;
    constexpr int RSLOT = 20480, NRING = 5, AHEAD = 4, OFF_HB = NRING * RSLOT;
    const int r32 = lane & 31, hi = lane >> 5, qr = 16 * iq + (r32 & 15), sw = (qr >> 1) & 7;
#define FRAG(M, rowb, s) ({ const int row_ = (rowb) + r32, k_ = (row_ >> 1) & 7; const u32x2 lo_ = *(const LAS u32x2*)((M) + row_ * 128 + (((2 * (s)) ^ k_) << 4) + 8 * hi); \
            const u32x2 hi_ = *(const LAS u32x2*)((M) + row_ * 128 + (((2 * (s) + 1) ^ k_) << 4) + 8 * hi); const u32x4 w_ = {lo_.x, lo_.y, hi_.x, hi_.y}; __builtin_bit_cast(bf16x8, w_); })
    if (wave >= 2) {
        if (wave < 7) {
        const int lw = wave - 2;
        unsigned soff[4];
#pragma unroll
        for (int k = 0; k < 4; ++k) { const int i = lw * 4 + k;
            const int mat = i < 16 ? (i >> 3) : (i < 18 ? 2 : 3), prow = (i < 16 ? (i & 7) : (i & 1)) * 8 + (lane >> 3), row = prow + (i < 16 ? 0 : 16 * iq), cp = lane & 7;
            soff[k] = (unsigned)(mat * 8192 + row * 128 + ((cp ^ ((row >> 1) & 7)) << 4)); }
#define DMA_CHUNK(c_) do { const unsigned char* rp_ = recs + (size_t)(c_) * REC_BYTES; LAS unsigned char* dp_ = lds + ((c_) % NRING) * RSLOT + lw * 4096; \
            _Pragma("unroll") for (int k = 0; k < 4; ++k) __builtin_amdgcn_global_load_lds((const unsigned*)(rp_ + soff[k]), (LAS unsigned*)(dp_ + k * 1024), 16, 0, 0); } while (0)
        DMA_CHUNK(0); DMA_CHUNK(1); DMA_CHUNK(2); DMA_CHUNK(3);
        asm volatile("s_waitcnt vmcnt(12)\n\ts_barrier" ::: "memory");
        for (int c = 0; c < NCHUNK; ++c) {
            if (c + AHEAD < NCHUNK) { DMA_CHUNK(c + AHEAD); asm volatile("s_waitcnt vmcnt(12)\n\ts_barrier" ::: "memory"); }
            else asm volatile("s_waitcnt vmcnt(0)\n\ts_barrier" ::: "memory");
        }
#undef DMA_CHUNK
        } else { for (int c = 0; c <= NCHUNK; ++c) asm volatile("s_barrier" ::: "memory"); }
    } else if (wave == 0) {
        f32x16 h0 = {}, h1 = {};
        bf16x8 hb[4];
#pragma unroll
        for (int s4 = 0; s4 < 4; ++s4) { const u32x4 z = {0u, 0u, 0u, 0u}; hb[s4] = __builtin_bit_cast(bf16x8, z); *(LAS u32x4*)(lds + OFF_HB + s4 * 1024 + lane * 16) = z; }
        CS_BAR();
        for (int c = 0; c < NCHUNK; ++c) {
            const LAS unsigned char* Pm = lds + (c % NRING) * RSLOT; const LAS unsigned char* Qm = Pm + 16384 - 16 * iq * 128;
            bf16x8 pa[2][4]; u32x2 qv[2][4];
#pragma unroll
            for (int s4 = 0; s4 < 4; ++s4) { pa[0][s4] = FRAG(Pm, 0, s4); pa[1][s4] = FRAG(Pm, 32, s4); }
#pragma unroll
            for (int g = 0; g < 4; ++g) { qv[0][g] = *(const LAS u32x2*)(Qm + qr * 128 + ((g ^ sw) << 4) + 8 * hi); qv[1][g] = *(const LAS u32x2*)(Qm + qr * 128 + (((4 + g) ^ sw) << 4) + 8 * hi); }
            asm volatile("s_waitcnt lgkmcnt(0)" ::: "memory"); __builtin_amdgcn_sched_barrier(0);
            f32x16 n0, n1;
#pragma unroll
            for (int g = 0; g < 4; ++g) { n0[4 * g] = bflo(qv[0][g].x); n0[4 * g + 1] = bfhi(qv[0][g].x); n0[4 * g + 2] = bflo(qv[0][g].y); n0[4 * g + 3] = bfhi(qv[0][g].y);
                n1[4 * g] = bflo(qv[1][g].x); n1[4 * g + 1] = bfhi(qv[1][g].x); n1[4 * g + 2] = bflo(qv[1][g].y); n1[4 * g + 3] = bfhi(qv[1][g].y); }
#pragma unroll
            for (int s4 = 0; s4 < 4; ++s4) { n0 = __builtin_amdgcn_mfma_f32_32x32x16_bf16(pa[0][s4], hb[s4], n0, 0, 0, 0); n1 = __builtin_amdgcn_mfma_f32_32x32x16_bf16(pa[1][s4], hb[s4], n1, 0, 0, 0); }
            h0 = n0; h1 = n1;
            LAS unsigned char* hbw = lds + OFF_HB + ((c + 1) & 1) * 4096 + lane * 16;
#pragma unroll
            for (int s4 = 0; s4 < 4; ++s4) { const f32x16& hs = (s4 < 2) ? h0 : h1; const int o = 8 * (s4 & 1);
                u32x4 w; w.x = cvt_pk_bf16(hs[o], hs[o + 1]); w.y = cvt_pk_bf16(hs[o + 2], hs[o + 3]); w.z = cvt_pk_bf16(hs[o + 4], hs[o + 5]); w.w = cvt_pk_bf16(hs[o + 6], hs[o + 7]);
                hb[s4] = __builtin_bit_cast(bf16x8, w); *(LAS u32x4*)(hbw + s4 * 1024) = w; }
            CS_BAR();
        }
    } else {
        CS_BAR();
        for (int c = 0; c < NCHUNK; ++c) {
            const LAS unsigned char* Pm = lds + (c % NRING) * RSLOT; const LAS unsigned char* Rm = Pm + 8192; const LAS unsigned char* Ym = Pm + 18432 - 16 * iq * 128;
            if (c >= CTXL / 64) {
                bf16x8 ra[2][4], hb[4]; u32x2 yv[2][4];
                const LAS unsigned char* hbr = lds + OFF_HB + (c & 1) * 4096 + lane * 16;
#pragma unroll
                for (int s4 = 0; s4 < 4; ++s4) { ra[0][s4] = FRAG(Rm, 0, s4); ra[1][s4] = FRAG(Rm, 32, s4); hb[s4] = *(const LAS bf16x8*)(hbr + s4 * 1024); }
#pragma unroll
                for (int g = 0; g < 4; ++g) { yv[0][g] = *(const LAS u32x2*)(Ym + qr * 128 + ((g ^ sw) << 4) + 8 * hi); yv[1][g] = *(const LAS u32x2*)(Ym + qr * 128 + (((4 + g) ^ sw) << 4) + 8 * hi); }
                asm volatile("s_waitcnt lgkmcnt(0)" ::: "memory"); __builtin_amdgcn_sched_barrier(0);
                f32x16 y0, y1;
#pragma unroll
                for (int g = 0; g < 4; ++g) { y0[4 * g] = bflo(yv[0][g].x); y0[4 * g + 1] = bfhi(yv[0][g].x); y0[4 * g + 2] = bflo(yv[0][g].y); y0[4 * g + 3] = bfhi(yv[0][g].y);
                    y1[4 * g] = bflo(yv[1][g].x); y1[4 * g + 1] = bfhi(yv[1][g].x); y1[4 * g + 2] = bflo(yv[1][g].y); y1[4 * g + 3] = bfhi(yv[1][g].y); }
#pragma unroll
                for (int s4 = 0; s4 < 4; ++s4) { y0 = __builtin_amdgcn_mfma_f32_32x32x16_bf16(ra[0][s4], hb[s4], y0, 0, 0, 0); y1 = __builtin_amdgcn_mfma_f32_32x32x16_bf16(ra[1][s4], hb[s4], y1, 0, 0, 0); }
                unsigned char* yo = recs + (size_t)c * REC_BYTES + 24576 + qr * 128 + 8 * hi;
#pragma unroll
                for (int g = 0; g < 4; ++g) { u32x2 w0, w1; w0.x = cvt_pk_bf16(y0[4 * g], y0[4 * g + 1]); w0.y = cvt_pk_bf16(y0[4 * g + 2], y0[4 * g + 3]); w1.x = cvt_pk_bf16(y1[4 * g], y1[4 * g + 1]); w1.y = cvt_pk_bf16(y1[4 * g + 2], y1[4 * g + 3]);
                    if (r32 < 16) { *(u32x2*)(yo + 16 * g) = w0; *(u32x2*)(yo + 64 + 16 * g) = w1; } }
            }
            CS_BAR();
        }
    }
#undef FRAG
}
#undef CS_BAR
#undef CS_AR
}

__device__ __forceinline__ void p5_finish(LAS unsigned char* lds, unsigned char* ws, int vb, int G) {
    const int tid = threadIdx.x, tk = tid >> 3, cg = tid & 7, wv = __builtin_amdgcn_readfirstlane(tid >> 6);
    const bf16_t* Urkv = (const bf16_t*)(ws + WS_URKV); bf16_t* Z = (bf16_t*)(ws + WS_UZ);
    const float* cff = (const float*)(ws + WS_COEF); const float* cfb = cff + (size_t)TX * 16;
    const float* cwp = kin(8); const float* lnw = kin(16); const float* lnb = kin(17);
    constexpr int NU = NB * RH * (SEQ / 64);
    constexpr int P5_YF = 0, P5_YB = 8192, P5_X0 = 16384, P5_X1 = 24576, P5_X2 = 32768, P5_ZW = 40960, P5_CF = 49152, P5_IMG = 53248;
    const unsigned yoff = (unsigned)((tid >> 3) * 128 + (((tid & 7) ^ wv) << 4));
#define P5_DMA(B_, u_) do { const int cf_ = (u_) & 127, h_ = ((u_) >> 7) & 15, b_ = (u_) >> 11; LAS unsigned char* img_ = lds + (B_) * P5_IMG; \
        const unsigned char* rf_ = ws + WS_SCAN + ((size_t)((0 * 2 + b_) * 16 + h_) * cs::NCHUNK + 4 + cf_) * REC_BYTES + 24576; \
        const unsigned char* rb_ = ws + WS_SCAN + ((size_t)((1 * 2 + b_) * 16 + h_) * cs::NCHUNK + 4 + (127 - cf_)) * REC_BYTES + 24576; \
        const int m_ = b_ * SEQ + cf_ * 64 + tk, tl_ = cf_ * 64 + tk; const bf16_t* p_ = Urkv + (size_t)m_ * LD_RKV + 2048 + h_ * 64 + cg * 8; \
        __builtin_amdgcn_global_load_lds((const unsigned*)(rf_ + yoff), (LAS unsigned*)(img_ + P5_YF + wv * 1024), 16, 0, 0); \
        __builtin_amdgcn_global_load_lds((const unsigned*)(rb_ + yoff), (LAS unsigned*)(img_ + P5_YB + wv * 1024), 16, 0, 0); \
        __builtin_amdgcn_global_load_lds((const unsigned*)(p_ - (tl_ > 0 ? LD_RKV : 0)), (LAS unsigned*)(img_ + P5_X0 + wv * 1024), 16, 0, 0); \
        __builtin_amdgcn_global_load_lds((const unsigned*)p_, (LAS unsigned*)(img_ + P5_X1 + wv * 1024), 16, 0, 0); \
        __builtin_amdgcn_global_load_lds((const unsigned*)(p_ + (tl_ < SEQ - 1 ? LD_RKV : 0)), (LAS unsigned*)(img_ + P5_X2 + wv * 1024), 16, 0, 0); \
        __builtin_amdgcn_global_load_lds((const unsigned*)(Z + (size_t)m_ * LD_Z + h_ * 64 + cg * 8), (LAS unsigned*)(img_ + P5_ZW + wv * 1024), 16, 0, 0); \
        __builtin_amdgcn_global_load_lds((const unsigned*)(cff + (size_t)m_ * 16 + h_), (LAS unsigned*)(img_ + P5_CF + wv * 256), 4, 0, 0); \
        __builtin_amdgcn_global_load_lds((const unsigned*)(cfb + (size_t)m_ * 16 + h_), (LAS unsigned*)(img_ + P5_CF + 2048 + wv * 256), 4, 0, 0); } while (0)
    for (int ub = vb; ub < NU / 16; ub += G) {
    const int u0 = ub * 16;
    float pc0[8], pc1[8], pc2[8], plw[8], plb[8];
    { const int chn0 = ((u0 >> 7) & 15) * 64 + cg * 8;
#pragma unroll
        for (int e = 0; e < 8; ++e) { pc0[e] = cwp[2048 + chn0 + e]; pc1[e] = cwp[3072 + 2048 + chn0 + e]; pc2[e] = cwp[2 * 3072 + 2048 + chn0 + e]; plw[e] = lnw[chn0 + e]; plb[e] = lnb[chn0 + e]; } }
    asm volatile("s_waitcnt vmcnt(0)" ::: "memory");
    __builtin_amdgcn_s_barrier();
    P5_DMA(0, u0); P5_DMA(1, u0 + 1);
    for (int k = 0; k < 16; ++k) {
        const int u = u0 + k, cf = u & 127, h = (u >> 7) & 15, b = u >> 11;
        const LAS unsigned char* img = lds + (k & 1) * P5_IMG;
        if (k < 15) asm volatile("s_waitcnt vmcnt(8)" ::: "memory"); else asm volatile("s_waitcnt vmcnt(0)" ::: "memory");
        __builtin_amdgcn_s_barrier();
        const int m = b * SEQ + cf * 64 + tk, tl = cf * 64 + tk, ch0 = h * 64 + cg * 8;
        const u32x4 qx0 = *(const LAS u32x4*)(img + P5_X0 + tid * 16), qx1 = *(const LAS u32x4*)(img + P5_X1 + tid * 16), qx2 = *(const LAS u32x4*)(img + P5_X2 + tid * 16), qzw = *(const LAS u32x4*)(img + P5_ZW + tid * 16);
        const float cf_ = *(const LAS float*)(img + P5_CF + tid * 4) + *(const LAS float*)(img + P5_CF + 2048 + tid * 4);
        float y[8]; float sy = 0.f; const int tb = 63 - tk;
#pragma unroll
        for (int e = 0; e < 8; ++e) { const int i = cg * 8 + e;
            y[e] = bf2f(*(const LAS bf16_t*)(img + P5_YF + i * 128 + (((tk >> 3) ^ cg) << 4) + (tk & 7) * 2)) + bf2f(*(const LAS bf16_t*)(img + P5_YB + i * 128 + (((tb >> 3) ^ cg) << 4) + (tb & 7) * 2)); sy += y[e]; }
        asm volatile("s_waitcnt lgkmcnt(0)" ::: "memory");
        __builtin_amdgcn_s_barrier();
        if (k + 2 < 16) P5_DMA(k & 1, u + 2);
        float xa[8], xb[8], xc[8], z[8];
        unpack8(qx0, xa); unpack8(qx1, xb); unpack8(qx2, xc); unpack8(qzw, z);
        const float wl = tl > 0 ? 1.f : 0.f, wr = tl < SEQ - 1 ? 1.f : 0.f;
        const float mu = cs::sum_oct(sy) * (1.f / 64.f);
        float sv = 0.f;
#pragma unroll
        for (int e = 0; e < 8; ++e) { y[e] -= mu; sv += y[e] * y[e]; }
        const float rstd = rsqrtf(cs::sum_oct(sv) * (1.f / 64.f) + GN_EPS);
        float o[8];
#pragma unroll
        for (int e = 0; e < 8; ++e) { const float v = pc0[e] * (wl * xa[e]) + pc1[e] * xb[e] + pc2[e] * (wr * xc[e]);
            o[e] = (y[e] * rstd * plw[e] + plb[e] + cf_ * v) * siluf_(z[e]); }
        *(u32x4*)(Z + (size_t)m * LD_Z + ch0) = pack8c(o);
    }
    }
    asm volatile("s_waitcnt vmcnt(0)" ::: "memory");
#undef P5_DMA
}

__device__ __forceinline__ void p7_mla(const Args& a, int gw, int NGW, int lane) {
    const bf16_t* Usm = (const bf16_t*)(a.ws + WS_USM); bf16_t* Q = (bf16_t*)(a.ws + WS_QRAW); bf16_t* KV = (bf16_t*)(a.ws + WS_KV); bf16_t* KR = (bf16_t*)(a.ws + WS_KR);
    const int h = lane >> 3, j = lane & 7;
    float qg0[8], qg1[8], qg2[8], kg0[8], kg1[8], kg2[8], inv[8];
    { const float* qg = kin(22); const float* kg = kin(23);
#pragma unroll
      for (int e = 0; e < 8; ++e) { qg0[e] = qg[8 * j + e]; qg1[e] = qg[64 + 8 * j + e]; qg2[e] = qg[128 + 8 * j + e]; kg0[e] = kg[8 * j + e]; kg1[e] = kg[64 + 8 * j + e]; kg2[e] = kg[128 + 8 * j + e];
          inv[e] = exp2f(-(float)(8 * (j & 1) + e) * 0.8304820237218406f); } }
    struct Row { u32x4 qd, kr, q0, q1, q2, k0, k1, v0, v1; u32x2 kvd; };
#define P7_LOAD(R, m_) do { const bf16_t* us_ = Usm + (size_t)(m_) * LD_SM; R.qd = *(const u32x4*)(us_ + 8 * lane); R.kvd = *(const u32x2*)(us_ + 512 + 4 * lane); R.kr = *(const u32x4*)(us_ + 1024 + 8 * j); \
        if ((m_) < TX) { const bf16_t* qp_ = Q + (size_t)(m_) * LD_Q + h * QKD + 8 * j; R.q0 = *(const u32x4*)qp_; R.q1 = *(const u32x4*)(qp_ + 64); R.q2 = *(const u32x4*)(qp_ + 128); } \
        const bf16_t* kp_ = KV + (size_t)(m_) * LD_KV + h * 256 + 8 * j; R.k0 = *(const u32x4*)kp_; R.k1 = *(const u32x4*)(kp_ + 64); R.v0 = *(const u32x4*)(kp_ + 128); R.v1 = *(const u32x4*)(kp_ + 192); } while (0)
    Row cur, nxt;
    if (gw < TT) P7_LOAD(cur, gw);
    for (int m = gw; m < TT; m += NGW) {
        if (m + NGW < TT) P7_LOAD(nxt, m + NGW);
        const bool latent = m < TX; const int tl = m % SEQ;
        const float pos = (float)((j < 4) ? (tl >> 6) : (tl & 63));
        float cs[8], sn[8];
#pragma unroll
        for (int e = 0; e < 8; ++e) { const float ang = pos * inv[e]; float t = ang * 0.15915494309189535f; t -= floorf(t); sn[e] = __builtin_amdgcn_sinf(t); cs[e] = __builtin_amdgcn_cosf(t); }
        float f[8];
        unpack8(cur.qd, f); const float s_q = rsqrtf(wave_sum(sum8sq(f)) * (1.f / QL) + EPS);
        { const float t0 = bflo(cur.kvd.x), t1 = bfhi(cur.kvd.x), t2 = bflo(cur.kvd.y), t3 = bfhi(cur.kvd.y); f[0] = (t0 * t0 + t1 * t1) + (t2 * t2 + t3 * t3); }
        const float s_kv = rsqrtf(wave_sum(f[0]) * (1.f / KVL) + EPS);
        float kr[8]; unpack8(cur.kr, kr);
        if (latent) {
            bf16_t* qp = Q + (size_t)m * LD_Q + h * QKD + 8 * j;
            float q0[8], q1[8], q2[8];
            unpack8(cur.q0, q0); unpack8(cur.q1, q1); unpack8(cur.q2, q2);
#pragma unroll
            for (int e = 0; e < 8; ++e) { q0[e] *= s_q; q1[e] *= s_q; q2[e] *= s_q; }
            const float rq = rsqrtf(cs::sum_oct(sum8sq(q0) + sum8sq(q1) + sum8sq(q2)) * (1.f / QKD) + EPS);
#pragma unroll
            for (int e = 0; e < 8; ++e) { q0[e] *= rq * qg0[e]; q1[e] *= rq * qg1[e]; q2[e] *= rq * qg2[e]; }
#pragma unroll
            for (int e = 0; e < 8; ++e) { const float pr = __int_as_float(__builtin_amdgcn_update_dpp(0, __float_as_int(q2[e]), 0x4E, 0xF, 0xF, true)); q2[e] = (j & 2) ? (q2[e] * cs[e] + pr * sn[e]) : (q2[e] * cs[e] - pr * sn[e]); }
            *(u32x4*)(qp) = pack8c(q0); *(u32x4*)(qp + 64) = pack8c(q1); *(u32x4*)(qp + 128) = pack8c(q2);
        }
        {
            bf16_t* kp = KV + (size_t)m * LD_KV + h * 256 + 8 * j;
            float k0[8], k1[8], v0[8], v1[8];
            unpack8(cur.k0, k0); unpack8(cur.k1, k1); unpack8(cur.v0, v0); unpack8(cur.v1, v1);
#pragma unroll
            for (int e = 0; e < 8; ++e) { k0[e] *= s_kv; k1[e] *= s_kv; v0[e] *= s_kv; v1[e] *= s_kv; }
            const float rk = rsqrtf(cs::sum_oct(sum8sq(k0) + sum8sq(k1) + sum8sq(kr)) * (1.f / QKD) + EPS);
            float ro[8];
#pragma unroll
            for (int e = 0; e < 8; ++e) { k0[e] *= rk * kg0[e]; k1[e] *= rk * kg1[e]; ro[e] = kr[e] * rk * kg2[e]; }
#pragma unroll
            for (int e = 0; e < 8; ++e) { const float pr = __int_as_float(__builtin_amdgcn_update_dpp(0, __float_as_int(ro[e]), 0x4E, 0xF, 0xF, true)); if (latent) ro[e] = (j & 2) ? (ro[e] * cs[e] + pr * sn[e]) : (ro[e] * cs[e] - pr * sn[e]); }
            *(u32x4*)(kp) = pack8c(k0); *(u32x4*)(kp + 64) = pack8c(k1); *(u32x4*)(kp + 128) = pack8c(v0); *(u32x4*)(kp + 192) = pack8c(v1);
            *(u32x4*)(KR + (size_t)m * LD_KR + h * 64 + 8 * j) = pack8c(ro);
        }
        cur = nxt;
    }
#undef P7_LOAD
}


#define XB_TMO      128
#define XB_XCNT(j)  (256  + 64 * (j))
#define XB_XSUB(j)  (1280 + 64 * (j))
#define XB_XGEN(j)  (2304 + 64 * (j))
#define XB_TOP      3328
#define XB_TOPGEN   3392
#define XCD_BAR_WORDS 3456
#define XB_SPIN_CAP (1u << 18)
__device__ __forceinline__ unsigned xb_ld(unsigned* p)              { return __hip_atomic_load(p, __ATOMIC_RELAXED, __HIP_MEMORY_SCOPE_AGENT); }
__device__ __forceinline__ unsigned xb_add(unsigned* p, unsigned v) { return __hip_atomic_fetch_add(p, v, __ATOMIC_RELAXED, __HIP_MEMORY_SCOPE_AGENT); }
__device__ __forceinline__ unsigned xb_xcc_id() { return (unsigned)__builtin_amdgcn_s_getreg((3 << 11) | 20) & 0xFu; }
#define XB_SPIN(cond, bar) do { unsigned _sp = 0; while (cond) { __builtin_amdgcn_s_sleep(1); \
    if ((++_sp & 255u) == 0u) { if (xb_ld(&(bar)[XB_TMO])) break; if (_sp > XB_SPIN_CAP) { atomicAdd(&(bar)[XB_TMO], 1u); break; } } } } while (0)
struct XcdBarrier { unsigned* bar; unsigned x; volatile LAS unsigned* st; };
__device__ __forceinline__ XcdBarrier xcd_barrier_post(unsigned* bar, volatile LAS unsigned* st) {
    XcdBarrier b; b.bar = bar; b.x = xb_xcc_id(); b.st = st;
    if (threadIdx.x == 0) (void)xb_add(&bar[XB_XCNT(b.x)], 1u);
    return b;
}
__device__ __forceinline__ void xcd_barrier_complete(unsigned* bar, unsigned x, unsigned& nloc, unsigned& nx) {
    const unsigned G = gridDim.x * gridDim.y * gridDim.z;
    unsigned sum, cnt, mine, sp = 0u;
    for (;;) {
        sum = 0u; cnt = 0u; mine = 0u;
#pragma unroll
        for (unsigned j = 0; j < 16; ++j) { const unsigned c = xb_ld(&bar[XB_XCNT(j)]); sum += c; cnt += (c > 0u) ? 1u : 0u; mine = (j == x) ? c : mine; }
        if (sum == G) break;
        __builtin_amdgcn_s_sleep(1);
        if ((++sp & 255u) == 0u) { if (xb_ld(&bar[XB_TMO])) break; if (sp > XB_SPIN_CAP) { atomicAdd(&bar[XB_TMO], 1u); break; } }
    }
    nloc = mine > 0u ? mine : 1u; nx = cnt > 0u ? cnt : 1u;
}
__device__ __forceinline__ void xcd_barrier(const XcdBarrier& b) {
    asm volatile("s_waitcnt vmcnt(0)" ::: "memory");
    __syncthreads();
    if (threadIdx.x == 0) {
        unsigned* bar = b.bar;
        __builtin_amdgcn_s_waitcnt(0);
        unsigned nloc = b.st[0], nx = b.st[1];
        if (nloc == 0u) { xcd_barrier_complete(bar, b.x, nloc, nx); b.st[0] = nloc; b.st[1] = nx; }
        const unsigned old = xb_add(&bar[XB_XSUB(b.x)], 1u);
        const unsigned gen = old / nloc;
        if (old + 1u == (gen + 1u) * nloc) {
            __builtin_amdgcn_fence(__ATOMIC_RELEASE, "agent");
            asm volatile("s_waitcnt vmcnt(0)" ::: "memory");
            const unsigned og = xb_add(&bar[XB_TOP], 1u);
            const unsigned tg = og / nx;
            if (og + 1u == (tg + 1u) * nx) xb_add(&bar[XB_TOPGEN], 1u);
            else XB_SPIN(xb_ld(&bar[XB_TOPGEN]) == tg, bar);
            __builtin_amdgcn_fence(__ATOMIC_ACQUIRE, "agent");
            xb_add(&bar[XB_XGEN(b.x)], 1u);
            asm volatile("s_waitcnt vmcnt(0)" ::: "memory");
        } else {
            XB_SPIN(xb_ld(&bar[XB_XGEN(b.x)]) == gen, bar);
            __builtin_amdgcn_fence(__ATOMIC_ACQUIRE, "agent");
            asm volatile("s_waitcnt vmcnt(0)" ::: "memory");
        }
    }
    __syncthreads();
}

constexpr int NPH = 11;
__global__ void __launch_bounds__(NTHREADS, 2) mega_fwd(Args args) {
    extern __shared__ __attribute__((aligned(16))) unsigned char lds_raw[];
    LAS unsigned char* lds = (LAS unsigned char*)lds_raw;
    cg::grid_group grid = cg::this_grid();
    const int tid = threadIdx.x, lane = tid & 63, wave = __builtin_amdgcn_readfirstlane(tid >> 6);
    const int G = gridDim.x, bx = blockIdx.x;
    const int vcu = (G % 8 == 0) ? (bx % 8) * (G / 8) + bx / 8 : bx;
    const int gw = vcu * NWAVES + wave, NGW = G * NWAVES;
    unsigned char* ws = args.ws;
    const int lo = args.ph_lo, hi = args.ph_hi;
    { volatile LAS unsigned* z = (volatile LAS unsigned*)(lds + LDS_BYTES - 256); if (tid < 64) z[tid] = 0u; }
    __syncthreads();
    XcdBarrier xbar = xcd_barrier_post((unsigned*)(ws + WS_CTL), (volatile LAS unsigned*)(lds + LDS_BYTES - 256 + 64));
#ifndef PHMASK
#define PHMASK 0x7ff
#endif
#ifndef PROBE_DUP
#define PROBE_DUP 0
#endif
#define DUP(k) for (int rep_ = 0; rep_ < (((PROBE_DUP >> (k)) & 1) ? 2 : 1); ++rep_)
#define IN(k) (((PHMASK >> (k)) & 1) && lo <= (k) && (k) < hi)
#define SEAM(k) do { if (IN(k) && IN((k) + 1)) { if ((k) == 0 && lo < -1000) grid.sync(); else xcd_barrier(xbar); } } while (0)

    constexpr int W_P0 = 512;
    if (IN(0)) DUP(0) { p0_mod(args, lds, bx, tid); if (bx >= 192 && G == 256) p0_weights<false>(args, lds, (bx - 192) * NWAVES + wave, 64 * NWAVES, wave, lane, 0, W_P0); }
    SEAM(0);
    if (IN(1)) DUP(1) { p1_hm(args, lds, gw, NGW, lane); __syncthreads(); p0_weights<false>(args, lds, gw, NGW, wave, lane, G == 256 ? W_P0 : 0); }
    SEAM(1);
    if (IN(2)) DUP(2) {
        pg8::Gemm g{(const bf16_t*)(ws + WS_HM), (const bf16_t*)(ws + WS_WIN), TT, NIN, DM, DM, DM}; pg8::StaticOrder S; S.init(TT, NIN, G, bx);
        pg8::EpiInProj E{(bf16_t*)(ws + WS_URKV), (bf16_t*)(ws + WS_UZ), (bf16_t*)(ws + WS_USM), (bf16_t*)args.out};
        pg8::gemm_phase<pg8::EpiInProj>(lds, g, S, E);
        { const int nfull = S.nwg / G, first_idle = S.nwg - nfull * G;
          if (bx >= first_idle) p0_weights<true>(args, lds, (bx - first_idle) * NWAVES + wave, (G - first_idle) * NWAVES, wave, lane); }
    }
    SEAM(2);
    if (IN(3)) DUP(3) { for (int u = bx; u < 256; u += G) cs::scan_stage1(lds, ws, u, tid, wave, lane); }
    SEAM(3);
    if (IN(4)) DUP(4) {
        for (int u = bx; u < 256; u += G) cs::scan_stage2(lds, ws, (u & 7) * 8 + ((u >> 3) >> 2), (u >> 3) & 3, tid, wave, lane); }
    SEAM(4);
    if (IN(5)) DUP(5) { p5_finish(lds, ws, vcu, G); }
    SEAM(5);
    if (IN(6)) DUP(6) {
        pg8::Gemm g{(const bf16_t*)(ws + WS_USM), (const bf16_t*)(ws + WS_WUQ), TX, 1536, 512, LD_SM, 512};
        pg8::DualOrder S; S.S0.init(TX, 1536, G, bx); S.S1.init(TT, 2048, G, G - 1 - bx); S.A1 = (const bf16_t*)(ws + WS_USM) + 512; S.B1 = (const bf16_t*)(ws + WS_WUKV); S.nt1 = 256 / pg8::BK;
        S.n0 = bx < S.S0.nwg ? (S.S0.nwg - bx + G - 1) / G : 0;
        pg8::EpiP6 E{(bf16_t*)(ws + WS_QRAW), (bf16_t*)(ws + WS_KV)}; pg8::gemm_phase<pg8::EpiP6, pg8::DualOrder>(lds, g, S, E);
    }
    SEAM(6);
    if (IN(7)) DUP(7) p7_mla(args, gw, NGW, lane);
    SEAM(7);
    if (IN(8)) DUP(8) {
        for (int u = vcu; u < NB * MH * (SEQ / 256); u += G) { const int bh = (u >> 5), qb = u & 31;
            att::attn_unit(bh / MH, bh % MH, qb, (const bf16_t*)(ws + WS_QRAW), (const bf16_t*)(ws + WS_KV), (const bf16_t*)(ws + WS_KR), nullptr, (bf16_t*)(ws + WS_UZ) + 1024, (char*)lds_raw); }
    }
    SEAM(8);
    if (IN(9)) DUP(9) {
        pg8::Gemm g{(const bf16_t*)(ws + WS_UZ), (const bf16_t*)(ws + WS_WBR), TX, DM, 1024, LD_Z, DM}; pg8::ChainOrder S; S.S.init(TX, DM, G, bx); S.KH = 1024;
        pg8::EpiBranchFused E{(const bf16_t*)args.out, (bf16_t*)(ws + WS_MB)}; pg8::gemm_phase<pg8::EpiBranchFused, pg8::ChainOrder>(lds, g, S, E);
    }
    SEAM(9);
    if (IN(10)) DUP(10) {
        pg8::Gemm g{(const bf16_t*)(ws + WS_MB), (const bf16_t*)(ws + WS_WOUT), TX, DM, DM, DM, DM}; pg8::StaticOrder S; S.init(TX, DM, G, bx);
        pg8::EpiOut E{kin(0), (const float*)(ws + WS_MOD), args.out};
        pg8::gemm_phase<pg8::EpiOut>(lds, g, S, E);
    }
#undef IN
#undef SEAM
}

extern "C" void kernel_launch(void* const* d_in, const int* in_sizes, int n_in, void* d_out, int out_size, void* d_ws, size_t ws_size, hipStream_t stream) {
    static int grid = 0;
    if (grid == 0) {
        if (n_in != 27 || out_size != TX * DM || ws_size < WS_END) { fprintf(stderr, "kernel_launch: unexpected shapes (n_in %d out %d ws %zu)\n", n_in, out_size, ws_size); grid = -1; return; }
        int dev = 0, cus = 0, per_cu = 0;
        hipGetDevice(&dev); hipDeviceGetAttribute(&cus, hipDeviceAttributeMultiprocessorCount, dev);
        hipFuncSetAttribute((const void*)mega_fwd, hipFuncAttributeMaxDynamicSharedMemorySize, LDS_BYTES);
        hipOccupancyMaxActiveBlocksPerMultiprocessor(&per_cu, (const void*)mega_fwd, NTHREADS, LDS_BYTES);
        (void)hipGetLastError();
        if (per_cu < 1) { fprintf(stderr, "kernel_launch: occupancy query says %d blocks per CU\n", per_cu); grid = -1; return; }
        grid = cus;
    }
    if (grid < 0) return;
    if (hipMemsetAsync((char*)d_ws + WS_CTL, 0, 16384, stream) != hipSuccess) { fprintf(stderr, "kernel_launch: memset failed\n"); return; }
    Args a{};
    for (int i = 0; i < 27; ++i) a.in[i] = (const float*)d_in[i];
    a.out = (float*)d_out; a.ws = (unsigned char*)d_ws;
#if MK_N_LAUNCHES == 1
    a.ph_lo = 0; a.ph_hi = NPH;
    void* kargs[] = {&a};
    hipError_t e = hipLaunchCooperativeKernel((const void*)mega_fwd, dim3(grid), dim3(NTHREADS), kargs, LDS_BYTES, stream);
    if (e != hipSuccess) fprintf(stderr, "cooperative launch failed: %s (grid %d)\n", hipGetErrorString(e), grid);
#else
    for (int p = 0; p < NPH; ++p) { a.ph_lo = p; a.ph_hi = p + 1; hipLaunchKernelGGL(mega_fwd, dim3(grid), dim3(NTHREADS), LDS_BYTES, stream, a); }
#endif
}
```
